# Optimizing an MI355X kernel written in HIP

```python
import jax, jax.numpy as jnp
from jax import lax
import numpy as np

D_MODEL = 1024
BATCH = 8
SEQ = 4096
DEPTH = 4

N_META = 16
N_A_LAYERS = DEPTH // 2
N_B_LAYERS = DEPTH - N_A_LAYERS
RET_HEADS = 4
RET_QK_DIM = D_MODEL // RET_HEADS
RET_V_DIM = 2 * D_MODEL // RET_HEADS
RET_CHUNK = 128
RET_PROJ = 2 * RET_HEADS * RET_QK_DIM + 2 * RET_HEADS * RET_V_DIM
SWA_HEADS = 16
SWA_KV_HEADS = 4
SWA_GROUP = SWA_HEADS // SWA_KV_HEADS
SWA_HEAD_DIM = 64
SWA_WINDOW = 128
FFN_HIDDEN = -(-8 * D_MODEL // (3 * 256)) * 256
RMS_EPS = 1e-6
GN_EPS = 1e-6

kernel_name = "retnet_yoco_swa_sink_alibi_meta_trunk"


def rms_norm(x, g):
    xf = x.astype(jnp.float32)
    y = xf * lax.rsqrt(jnp.mean(xf * xf, axis=-1, keepdims=True) + RMS_EPS)
    return (y * g.astype(jnp.float32)).astype(x.dtype)


def swiglu(x, w_in, w_out):
    gate, up = jnp.split(x @ w_in, 2, axis=-1)
    return (jax.nn.silu(gate) * up) @ w_out


def retention_log_decay():
    return jnp.log1p(-jnp.exp2(-5.0 - jnp.arange(RET_HEADS, dtype=jnp.float32)))


def alibi_slopes():
    return jnp.exp2(-8.0 * (jnp.arange(SWA_HEADS, dtype=jnp.float32) + 1.0) / SWA_HEADS)


def retention(x, w_in, w_out):
    B, L, _ = x.shape
    H, dk, dv, C = RET_HEADS, RET_QK_DIM, RET_V_DIM, RET_CHUNK
    pad = C - N_META
    nc = (L + pad) // C
    q, k, v, g = jnp.split(x @ w_in, [H * dk, 2 * H * dk, 2 * H * dk + H * dv], axis=-1)

    def chunks(t, d):
        return jnp.pad(t, ((0, 0), (pad, 0), (0, 0))).reshape(B, nc, C, H, d)

    q = chunks(q, dk) * (dk ** -0.5)
    k = chunks(k, dk)
    v = chunks(v, dv)
    log_gamma = retention_log_decay()
    i = jnp.arange(C, dtype=jnp.float32)
    diff = i[:, None] - i[None, :]
    decay_intra = jnp.where(diff >= 0, jnp.exp(log_gamma[:, None, None] * jnp.maximum(diff, 0.0)), 0.0)
    scores = jnp.einsum('bnchd,bnshd->bnhcs', q, k) * decay_intra
    intra = jnp.einsum('bnhcs,bnshe->bnche', scores, v)
    zeta = jnp.exp(log_gamma[:, None] * (C - 1.0 - i)[None, :])
    xi = jnp.exp(log_gamma[:, None] * (i + 1.0)[None, :])
    chunk_decay = jnp.exp(log_gamma * C)[None, :, None, None]

    def step(state, xs):
        qc, kc, vc = xs
        inter = jnp.einsum('bchd,hc,bhde->bche', qc, xi, state)
        state = state * chunk_decay + jnp.einsum('bshd,hs,bshe->bhde', kc, zeta, vc)
        return state, inter

    state0 = jnp.zeros((B, H, dk, dv), jnp.float32)
    _, inter = lax.scan(step, state0, (jnp.moveaxis(q, 1, 0), jnp.moveaxis(k, 1, 0), jnp.moveaxis(v, 1, 0)))
    o = intra + jnp.moveaxis(inter, 0, 1)
    o = o.reshape(B, nc * C, H, dv)[:, pad:].astype(jnp.float32)
    mu = jnp.mean(o, axis=-1, keepdims=True)
    var = jnp.mean(jnp.square(o - mu), axis=-1, keepdims=True)
    o = ((o - mu) * lax.rsqrt(var + GN_EPS)).astype(x.dtype).reshape(B, L, H * dv)
    return (jax.nn.silu(g) * o) @ w_out


def shared_kv(h, g, w_kv):
    B, L, _ = h.shape
    k, v = jnp.split(rms_norm(h, g) @ w_kv, 2, axis=-1)
    k = k.reshape(B, L, SWA_KV_HEADS, SWA_HEAD_DIM)
    v = v.reshape(B, L, SWA_KV_HEADS, SWA_HEAD_DIM)
    return k[:, :N_META], v[:, :N_META], k[:, N_META:], v[:, N_META:]


def sliding_window_attention(x, w_q, w_o, sinks, k_meta, v_meta, k_real, v_real):
    B, S, _ = x.shape
    W = SWA_WINDOW
    nb = S // W
    q = (x @ w_q).reshape(B, nb, W, SWA_KV_HEADS, SWA_GROUP, SWA_HEAD_DIM) * (SWA_HEAD_DIM ** -0.5)

    def band(t):
        tp = jnp.pad(t, ((0, 0), (W, 0), (0, 0), (0, 0))).reshape(B, nb + 1, W, SWA_KV_HEADS, SWA_HEAD_DIM)
        return jnp.concatenate([tp[:, :-1], tp[:, 1:]], axis=2)

    k_band, v_band = band(k_real), band(v_real)
    slopes = alibi_slopes().reshape(SWA_KV_HEADS, SWA_GROUP)[:, :, None, None, None]
    r = jnp.arange(W)
    c = jnp.arange(2 * W)
    blk = jnp.arange(nb)
    dist = W + r[:, None] - c[None, :]
    mask = (dist >= 0) & (dist < W) & ((blk[:, None, None] * W + c[None, None, :]) >= W)
    s_band = jnp.einsum('bnrkgd,bnckd->bkgnrc', q, k_band).astype(jnp.float32) - slopes * dist.astype(jnp.float32)
    s_band = jnp.where(mask, s_band, -jnp.inf)
    q_pos = N_META + blk[:, None] * W + r[None, :]
    meta_dist = (q_pos[:, :, None] - jnp.arange(N_META)[None, None, :]).astype(jnp.float32)
    s_meta = jnp.einsum('bnrkgd,bmkd->bkgnrm', q, k_meta).astype(jnp.float32) - slopes * meta_dist
    s_sink = sinks.astype(jnp.float32).reshape(SWA_KV_HEADS, SWA_GROUP)[None, :, :, None, None]
    m = jnp.maximum(jnp.maximum(s_band.max(-1), s_meta.max(-1)), s_sink)
    e_band = jnp.exp(s_band - m[..., None])
    e_meta = jnp.exp(s_meta - m[..., None])
    inv = 1.0 / (e_band.sum(-1) + e_meta.sum(-1) + jnp.exp(s_sink - m))
    p_band = (e_band * inv[..., None]).astype(v_band.dtype)
    p_meta = (e_meta * inv[..., None]).astype(v_meta.dtype)
    o = (jnp.einsum('bkgnrc,bnckd->bnrkgd', p_band, v_band)
         + jnp.einsum('bkgnrm,bmkd->bnrkgd', p_meta, v_meta))
    return o.reshape(B, S, SWA_HEADS * SWA_HEAD_DIM).astype(x.dtype) @ w_o


def setup_inputs(seed: int = 0) -> dict:
    key = jax.random.key(seed)
    ks = jax.random.split(key, 14)
    resid_scale = (2.0 * DEPTH) ** -0.5

    def nrm(k, shape, fan_in, scale=1.0):
        return jax.random.normal(k, shape, jnp.float32) * (scale * fan_in ** -0.5)

    def gain(k, shape):
        return 1.0 + 0.02 * jax.random.normal(k, shape, jnp.float32)

    return {
        "x": jax.random.normal(ks[0], (BATCH, SEQ, D_MODEL), jnp.float32),
        "meta_tokens": jax.random.normal(ks[1], (N_META, D_MODEL), jnp.float32),
        "mix_norm": gain(ks[2], (DEPTH, D_MODEL)),
        "ffn_norm": gain(ks[3], (DEPTH, D_MODEL)),
        "ret_w_in": nrm(ks[4], (N_A_LAYERS, D_MODEL, RET_PROJ), D_MODEL),
        "ret_w_out": nrm(ks[5], (N_A_LAYERS, RET_HEADS * RET_V_DIM, D_MODEL), RET_HEADS * RET_V_DIM, resid_scale),
        "kv_norm": gain(ks[6], (D_MODEL,)),
        "kv_w": nrm(ks[7], (D_MODEL, 2 * SWA_KV_HEADS * SWA_HEAD_DIM), D_MODEL),
        "swa_w_q": nrm(ks[8], (N_B_LAYERS, D_MODEL, SWA_HEADS * SWA_HEAD_DIM), D_MODEL),
        "swa_w_o": nrm(ks[9], (N_B_LAYERS, SWA_HEADS * SWA_HEAD_DIM, D_MODEL), SWA_HEADS * SWA_HEAD_DIM, resid_scale),
        "swa_sinks": 0.5 * jax.random.normal(ks[10], (N_B_LAYERS, SWA_HEADS), jnp.float32),
        "ffn_w_in": nrm(ks[11], (DEPTH, D_MODEL, 2 * FFN_HIDDEN), D_MODEL),
        "ffn_w_out": nrm(ks[12], (DEPTH, FFN_HIDDEN, D_MODEL), FFN_HIDDEN, resid_scale),
        "final_norm": gain(ks[13], (D_MODEL,)),
    }


def reference(x, meta_tokens, mix_norm, ffn_norm, ret_w_in, ret_w_out, kv_norm, kv_w,
              swa_w_q, swa_w_o, swa_sinks, ffn_w_in, ffn_w_out, final_norm):
    B = x.shape[0]
    meta = jnp.broadcast_to(meta_tokens.astype(x.dtype)[None], (B, N_META, D_MODEL))
    h = jnp.concatenate([meta, x], axis=1)
    k_meta = v_meta = k_real = v_real = None
    for layer in range(DEPTH):
        if layer < N_A_LAYERS:
            h = h + retention(rms_norm(h, mix_norm[layer]), ret_w_in[layer], ret_w_out[layer])
        else:
            if layer == N_A_LAYERS:
                k_meta, v_meta, k_real, v_real = shared_kv(h, kv_norm, kv_w)
                h = h[:, N_META:]
            b = layer - N_A_LAYERS
            h = h + sliding_window_attention(rms_norm(h, mix_norm[layer]), swa_w_q[b], swa_w_o[b], swa_sinks[b],
                                             k_meta, v_meta, k_real, v_real)
        h = h + swiglu(rms_norm(h, ffn_norm[layer]), ffn_w_in[layer], ffn_w_out[layer])
    return rms_norm(h, final_norm)
```

```cpp
#include <hip/hip_runtime.h>
#include <hip/hip_cooperative_groups.h>
#include <cstdio>
#include <cstdint>
namespace cg = cooperative_groups;
#ifndef MK_MULTI
#define MK_MULTI 0
#endif
#ifndef PROBE_SEQ
#define PROBE_SEQ 0
#endif
namespace pg8 {
#define PG8_LAS __attribute__((address_space(3)))
typedef unsigned short bf16_t;
typedef short bf16x8 __attribute__((ext_vector_type(8)));
typedef float f32x4 __attribute__((ext_vector_type(4)));
typedef unsigned u32x4 __attribute__((ext_vector_type(4)));
constexpr int BM = 256, BK = 64, HALF = 128, HTB = HALF * BK * 2  , STAGE_BYTES = 8 * HTB, NXCD = 8, WGM = 8;

__host__ __device__ __forceinline__ int lds_byte(int r, int c) { const int st = (r >> 4) * 2 + (c >> 5), rr = r & 15, cc = c & 31, ob = rr * 64 + cc * 2; return st * 1024 + (ob ^ (((ob >> 9) & 1) << 5)); }
__host__ __device__ __forceinline__ void stage_rc(int b, int& R, int& C) { const int st = b / 1024, sb = b % 1024, swz = sb ^ (((sb >> 9) & 1) << 5); R = (st >> 1) * 16 + swz / 64; C = (st & 1) * 32 + (swz % 64) / 2; }
__host__ __device__ __forceinline__ int perm32(int rho) { const int n = rho >> 4, i = rho & 15; return 8 * (i >> 2) + 4 * n + (i & 3); }

struct Unit { int pm, pn; };
struct Gemm { const bf16_t* A; const bf16_t* Bt; int M, N, K; };

struct StaticOrder {
    int nM, nN, nwg, G, c;
    __host__ __device__ void init(int M, int N, int G_, int c_) { nM = M / BM; nN = N / BM; nwg = nM * nN; G = G_; c = c_; }
    __host__ __device__ bool next(int i, Unit& u) const {
        const long L = (long)i * G + c; if (L >= nwg) return false;
        int wgid = (int)L; { const int q = nwg / NXCD, r = nwg % NXCD, xcd = wgid % NXCD, off = wgid / NXCD; wgid = (xcd < r ? xcd * (q + 1) : r * (q + 1) + (xcd - r) * q) + off; }
        const int nig = WGM * nN, gid = wgid / nig, fm = gid * WGM, gsz = (nM - fm) < WGM ? (nM - fm) : WGM;
        u.pm = fm + ((wgid % nig) % gsz); u.pn = (wgid % nig) / gsz; return true;
    }
    __device__ __forceinline__ void a_ready(const Unit&) const {}
    __device__ __forceinline__ void done(const Unit&) const {}
};


template <class Epi, class Sched, bool ALIGN_EPI = false, bool SP2 = false>
__device__ __forceinline__ void gemm_phase(PG8_LAS unsigned char* lds, const Gemm g, const Sched& S, const Epi& E) {
    int tid_l = threadIdx.x; asm volatile("" : "+v"(tid_l));
    const int tid = tid_l, wid = __builtin_amdgcn_readfirstlane(tid >> 6), lane = tid & 63, wr = wid >> 2, wc = wid & 3, fr = lane & 15, fq = lane >> 4;
    const int K = g.K, nt = K / BK;
    unsigned voffA[2], voffB[2];
#pragma unroll
    for (int i = 0; i < 2; ++i) { int R, C; stage_rc(tid * 16 + i * 8192, R, C); const int Rb = Epi::PERM ? ((R & ~31) + perm32(R & 31)) : R;
        voffA[i] = (unsigned)(R * K + C) * 2u; voffB[i] = (unsigned)(Rb * K + C) * 2u; }
    const size_t kstep = (size_t)(BK * 2);
    const size_t hstep = (size_t)HALF * K * 2;
    const size_t tstep = 2 * hstep;
    const unsigned ldsw = (unsigned)wid * 1024u;
    const int aoff = lds_byte(wr * 64 + fr, fq * 8), boff = lds_byte(wc * 32 + fr, fq * 8);
#define PG8_SA(b, h) (((b) * 2 + (h)) * HTB)
#define PG8_SB(b, h) ((4 + (b) * 2 + (h)) * HTB)
#define PG8_STAGE(bufoff, gbase, voff) do { _Pragma("unroll") for (int _i = 0; _i < 2; ++_i) \
        __builtin_amdgcn_global_load_lds((const unsigned*)((const char*)(gbase) + (voff)[_i]), (PG8_LAS unsigned*)(lds + (bufoff) + ldsw + _i * 8192), 16, 0, 0); } while (0)
#define PG8_LDA(dst, b, h) do { _Pragma("unroll") for (int m = 0; m < 4; ++m) _Pragma("unroll") for (int k = 0; k < 2; ++k) dst[m][k] = *(const PG8_LAS bf16x8*)(lds + PG8_SA(b, h) + aoff + m * 2048 + k * 1024); } while (0)
#define PG8_LDB(dst, b, h) do { _Pragma("unroll") for (int n = 0; n < 2; ++n) _Pragma("unroll") for (int k = 0; k < 2; ++k) dst[n][k] = *(const PG8_LAS bf16x8*)(lds + PG8_SB(b, h) + boff + n * 2048 + k * 1024); } while (0)
#define PG8_MMA(ai, bj, At, Bt) do { __builtin_amdgcn_s_setprio(1); _Pragma("unroll") for (int m = 0; m < 4; ++m) _Pragma("unroll") for (int n = 0; n < 2; ++n) _Pragma("unroll") for (int k = 0; k < 2; ++k) \
        acc[ai][bj][m][n] = __builtin_amdgcn_mfma_f32_16x16x32_bf16(Bt[n][k], At[m][k], acc[ai][bj][m][n], 0, 0, 0); __builtin_amdgcn_s_setprio(0); } while (0)
#define PG8_WAIT_V(n) asm volatile("s_waitcnt vmcnt(" #n ")" ::: "memory")
#define PG8_WAIT_L(n) asm volatile("s_waitcnt lgkmcnt(" #n ")" ::: "memory")
#define PG8_BAR __builtin_amdgcn_s_barrier()
#define PG8_SCHED __builtin_amdgcn_sched_barrier(0)
    Unit cur, nxt; int ui = 0;
    if (!S.next(0, cur)) return;
    f32x4 acc[2][2][4][2];
#pragma unroll
    for (int a = 0; a < 2; ++a)
#pragma unroll
        for (int b = 0; b < 2; ++b)
#pragma unroll
            for (int m = 0; m < 4; ++m)
#pragma unroll
                for (int n = 0; n < 2; ++n) acc[a][b][m][n] = (f32x4){0.f, 0.f, 0.f, 0.f};
    bf16x8 At[4][2], B0[2][2], B1[2][2];
    const char* cA = (const char*)g.A + (size_t)cur.pm * tstep; const char* cB = (const char*)g.Bt + (size_t)cur.pn * tstep;
    S.a_ready(cur);
    if constexpr (SP2) {
        PG8_STAGE(PG8_SB(0, 0), cB, voffB); PG8_STAGE(PG8_SB(0, 1), cB + hstep, voffB); PG8_STAGE(PG8_SA(0, 0), cA, voffA); PG8_STAGE(PG8_SA(0, 1), cA + hstep, voffA);
        if (wr == 1) PG8_BAR;
        PG8_WAIT_V(2); PG8_BAR;
        PG8_STAGE(PG8_SB(1, 0), cB + kstep, voffB); PG8_STAGE(PG8_SA(1, 0), cA + kstep, voffA); PG8_STAGE(PG8_SB(1, 1), cB + hstep + kstep, voffB);
        PG8_WAIT_V(6); PG8_BAR;
    } else {
        PG8_STAGE(PG8_SB(0, 0), cB, voffB); PG8_STAGE(PG8_SA(0, 0), cA, voffA); PG8_STAGE(PG8_SB(0, 1), cB + hstep, voffB); PG8_STAGE(PG8_SA(0, 1), cA + hstep, voffA);
        if (wr == 1) PG8_BAR;
        PG8_WAIT_V(4); PG8_BAR;
        PG8_STAGE(PG8_SB(1, 0), cB + kstep, voffB); PG8_STAGE(PG8_SA(1, 0), cA + kstep, voffA); PG8_STAGE(PG8_SB(1, 1), cB + hstep + kstep, voffB);
        PG8_WAIT_V(6); PG8_BAR;
    }
    for (;;) {
        const bool has_next = S.next(ui + 1, nxt);
        const char* nA = has_next ? (const char*)g.A + (size_t)nxt.pm * tstep : cA; const char* nB = has_next ? (const char*)g.Bt + (size_t)nxt.pn * tstep : cB;
        for (int t = 0; t < nt; t += 2) {
            const bool last = (t == nt - 2);
            const char* a1 = cA + (size_t)(t + 1) * kstep;
            const char* a2 = last ? nA : cA + (size_t)(t + 2) * kstep; const char* b2 = last ? nB : cB + (size_t)(t + 2) * kstep;
            const char* a3 = a2 + kstep; const char* b3 = b2 + kstep;
            if (last && has_next) S.a_ready(nxt);
            if constexpr (SP2) {
            PG8_LDB(B0, 0, 0); PG8_LDB(B1, 0, 1); PG8_SCHED; PG8_LDA(At, 0, 0); PG8_STAGE(PG8_SA(1, 1), a1 + hstep, voffA);
            PG8_WAIT_V(8); PG8_WAIT_L(0); PG8_BAR; PG8_MMA(0, 0, At, B0); PG8_MMA(0, 1, At, B1); PG8_BAR; PG8_SCHED;
            PG8_LDA(At, 0, 1); PG8_STAGE(PG8_SB(0, 0), b2, voffB); PG8_STAGE(PG8_SB(0, 1), b2 + hstep, voffB); PG8_STAGE(PG8_SA(0, 0), a2, voffA);
            PG8_WAIT_V(8); PG8_WAIT_L(0); PG8_BAR; PG8_MMA(1, 0, At, B0); PG8_MMA(1, 1, At, B1); PG8_BAR; PG8_SCHED;
            PG8_LDB(B0, 1, 0); PG8_LDB(B1, 1, 1); PG8_SCHED; PG8_LDA(At, 1, 0); PG8_STAGE(PG8_SA(0, 1), a2 + hstep, voffA);
            PG8_WAIT_V(8); PG8_WAIT_L(0); PG8_BAR; PG8_MMA(0, 0, At, B0); PG8_MMA(0, 1, At, B1); PG8_BAR; PG8_SCHED;
            PG8_LDA(At, 1, 1); PG8_STAGE(PG8_SB(1, 0), b3, voffB); PG8_STAGE(PG8_SB(1, 1), b3 + hstep, voffB); PG8_STAGE(PG8_SA(1, 0), a3, voffA);
            PG8_WAIT_V(8); PG8_WAIT_L(0); PG8_BAR; PG8_MMA(1, 0, At, B0); PG8_MMA(1, 1, At, B1); PG8_BAR; PG8_SCHED;
            } else {
            PG8_LDB(B0, 0, 0); PG8_SCHED; PG8_LDA(At, 0, 0); PG8_STAGE(PG8_SA(1, 1), a1 + hstep, voffA);
            PG8_WAIT_L(8); PG8_BAR; PG8_WAIT_L(0); PG8_MMA(0, 0, At, B0); PG8_BAR; PG8_SCHED;
            PG8_LDB(B1, 0, 1); PG8_STAGE(PG8_SB(0, 0), b2, voffB);
            PG8_BAR; PG8_WAIT_L(0); PG8_MMA(0, 1, At, B1); PG8_BAR;
            PG8_LDA(At, 0, 1); PG8_STAGE(PG8_SA(0, 0), a2, voffA);
            PG8_BAR; PG8_WAIT_L(0); PG8_MMA(1, 0, At, B0); PG8_BAR; PG8_SCHED;
            PG8_STAGE(PG8_SB(0, 1), b2 + hstep, voffB);
            PG8_WAIT_V(6); PG8_BAR; PG8_MMA(1, 1, At, B1); PG8_BAR;
            PG8_LDB(B0, 1, 0); PG8_SCHED; PG8_LDA(At, 1, 0); PG8_STAGE(PG8_SA(0, 1), a2 + hstep, voffA);
            PG8_WAIT_L(8); PG8_BAR; PG8_WAIT_L(0); PG8_MMA(0, 0, At, B0); PG8_BAR; PG8_SCHED;
            PG8_LDB(B1, 1, 1); PG8_STAGE(PG8_SB(1, 0), b3, voffB);
            PG8_BAR; PG8_WAIT_L(0); PG8_MMA(0, 1, At, B1); PG8_BAR;
            PG8_LDA(At, 1, 1); PG8_STAGE(PG8_SA(1, 0), a3, voffA);
            PG8_BAR; PG8_WAIT_L(0); PG8_MMA(1, 0, At, B0); PG8_BAR; PG8_SCHED;
            PG8_STAGE(PG8_SB(1, 1), b3 + hstep, voffB);
            PG8_WAIT_V(6); PG8_BAR; PG8_MMA(1, 1, At, B1); PG8_BAR;
            }
        }
        if constexpr (ALIGN_EPI) { if (wr == 0) PG8_BAR; }
        if constexpr (!Epi::AFTER_DRAIN) { E(acc, cur, wr, wc, fr, fq); S.done(cur); }
        if (!has_next) break;
#pragma unroll
        for (int a = 0; a < 2; ++a)
#pragma unroll
            for (int b = 0; b < 2; ++b)
#pragma unroll
                for (int m = 0; m < 4; ++m)
#pragma unroll
                    for (int n = 0; n < 2; ++n) acc[a][b][m][n] = (f32x4){0.f, 0.f, 0.f, 0.f};
        cur = nxt; cA = nA; cB = nB; ++ui;
        if constexpr (ALIGN_EPI) { if (wr == 1) PG8_BAR; }
    }
    PG8_WAIT_V(0);
    if constexpr (!ALIGN_EPI) { if (wr == 0) PG8_BAR; }
    PG8_BAR;
    if constexpr (Epi::AFTER_DRAIN) { E.fused(acc, cur, wr, wc, fr, fq, lds, wid, lane); S.done(cur); }
#undef PG8_SA
#undef PG8_SB
#undef PG8_STAGE
#undef PG8_LDA
#undef PG8_LDB
#undef PG8_MMA
#undef PG8_WAIT_V
#undef PG8_WAIT_L
#undef PG8_BAR
#undef PG8_SCHED
}
}

constexpr int DM = 1024, MREAL = 32768, MP = 33024, FFH = 2816;
constexpr size_t MiB = 1u << 20;
constexpr size_t WS_CTL = 0;
constexpr size_t WS_SSQ = 1 * MiB;
constexpr size_t WS_HMETA = 4 * MiB;
constexpr size_t WS_OMETA = 5 * MiB;
constexpr size_t WS_HB = 8 * MiB;
constexpr size_t WS_WT = 73 * MiB;
constexpr size_t WS_T = 180 * MiB;
constexpr size_t WS_Q = WS_T;
constexpr size_t WS_K = WS_T + 65 * MiB;
constexpr size_t WS_VO = WS_T + 130 * MiB;
constexpr size_t WS_P = WS_T + 259 * MiB;
constexpr size_t WS_STATS = WS_T + 292 * MiB;
constexpr size_t WS_ACT = WS_T;
constexpr size_t WS_END = 512 * MiB;
static_assert(WS_STATS + (size_t)MP * 4 * 32 * 4 <= WS_END, "ws map");
static_assert(WS_P + (size_t)32 * 33 * 16384 * 2 <= WS_STATS, "ws map");
static_assert(WS_HB + (size_t)MP * 1024 * 2 <= WS_WT, "ws map");
constexpr size_t WO_WIN = 0, WO_WOUT = 12582912, WO_FFI = 16777216, WO_FFO = 39845888, WO_QKV2 = 51380224, WO_Q3 = 52953088, WO_WO = 54001664, WO_END = 56098816;
static_assert(WS_WT + WO_END * 2 <= WS_T, "ws map");

#define LAS __attribute__((address_space(3)))
typedef unsigned short bf16_t;
typedef short bf16x8 __attribute__((ext_vector_type(8)));
typedef short v4i16_t __attribute__((ext_vector_type(4)));
typedef float f32x4 __attribute__((ext_vector_type(4)));
typedef float f32x16 __attribute__((ext_vector_type(16)));
typedef unsigned u32x4 __attribute__((ext_vector_type(4)));
typedef unsigned u32x2 __attribute__((ext_vector_type(2)));
typedef float f32x2_t __attribute__((ext_vector_type(2)));
typedef __bf16 bf16x2_t __attribute__((ext_vector_type(2)));
#define MFMA32(a, b, c) __builtin_amdgcn_mfma_f32_32x32x16_bf16((a), (b), (c), 0, 0, 0)
#define DI __device__ __forceinline__
DI unsigned pk2(float lo, float hi) { f32x2_t v = {lo, hi}; bf16x2_t b = __builtin_convertvector(v, bf16x2_t); return __builtin_bit_cast(unsigned, b); }
DI float bflo(unsigned u) { return __builtin_bit_cast(float, u << 16); }
DI float bfhi(unsigned u) { return __builtin_bit_cast(float, u & 0xffff0000u); }
DI int crow(int reg, int h) { return (reg & 3) + 8 * (reg >> 2) + 4 * h; }
DI float siluf(float g) { return g * __builtin_amdgcn_rcpf(1.f + __builtin_amdgcn_exp2f(g * -1.4426950408889634f)); }
DI float row_rstd(const float* ssq, int r) {
    const f32x4* p = (const f32x4*)(ssq + (size_t)r * 16);
    const f32x4 a = p[0], b = p[1], c = p[2], d = p[3];
    const float s = ((a.x + a.y) + (a.z + a.w)) + ((b.x + b.y) + (b.z + b.w)) + ((c.x + c.y) + (c.z + c.w)) + ((d.x + d.y) + (d.z + d.w));
    return rsqrtf(s * (1.f / 1024.f) + 1e-6f);
}
DI float xsum_row4(float v) {
    v += __shfl_xor(v, 16); v += __shfl_xor(v, 32); return v;
}
DI float rstd_of(const f32x4 a) { return rsqrtf(xsum_row4((a.x + a.y) + (a.z + a.w)) * (1.f / 1024.f) + 1e-6f); }
DI float row_rstd4(const float* ssq, int r, int fq) {
    const f32x4 a = *(const f32x4*)(ssq + (size_t)r * 16 + 4 * fq);
    float s = (a.x + a.y) + (a.z + a.w); s += __shfl_xor(s, 16); s += __shfl_xor(s, 32);
    return rsqrtf(s * (1.f / 1024.f) + 1e-6f);
}
DI float head_l2g(int h) { return __builtin_amdgcn_logf(1.f - __builtin_amdgcn_exp2f(-5.f - (float)h)); }
DI const void* karg(int i) { const __attribute__((address_space(4))) char* k = (const __attribute__((address_space(4))) char*)__builtin_amdgcn_kernarg_segment_ptr(); return *(const void* const volatile __attribute__((address_space(4)))*)(k + 8 * i); }
DI int karg_b(int off) { const __attribute__((address_space(4))) char* k = (const __attribute__((address_space(4))) char*)__builtin_amdgcn_kernarg_segment_ptr(); return *(const volatile __attribute__((address_space(4))) unsigned char*)(k + off); }
DI int karg_i(int off) { const __attribute__((address_space(4))) char* k = (const __attribute__((address_space(4))) char*)__builtin_amdgcn_kernarg_segment_ptr(); return *(const volatile __attribute__((address_space(4))) int*)(k + off); }
#define KIN(i) ((const float*)karg(i))
#define KOUT ((float*)karg(14))
#define KWS ((unsigned char*)karg(15))

namespace pg8 {
struct EpiRetIn {
    static constexpr bool PERM = true, AFTER_DRAIN = false;
    unsigned char* ws; const float* ssq;
    __device__ __forceinline__ void operator()(const f32x4 (&acc)[2][2][4][2], const Unit& u, int wr, int wc, int fr, int fq) const {
        const int pn = u.pn, kind = pn < 4 ? 0 : (pn < 8 ? 1 : 2), head = pn & 3;
        const float l2g = __builtin_amdgcn_logf(1.f - __builtin_amdgcn_exp2f(-5.f - (float)head));
        bf16_t* base = (bf16_t*)(ws + WS_Q + (size_t)kind * (65 * MiB));
        const int ldc = 1024 << (kind >> 1), colt = (kind == 2 ? pn - 8 : head) * 256;
        const int col0 = colt + wc * 32 + 8 * fq;
        const float sgn = kind == 0 ? l2g : (kind == 1 ? -l2g : 0.f), mul = kind == 0 ? 0.0625f : 1.f;
        const int r0 = u.pm * BM + wr * 64 + fr;
        f32x4 pq[2][4];
#pragma unroll
        for (int ai = 0; ai < 2; ++ai)
#pragma unroll
            for (int m = 0; m < 4; ++m) pq[ai][m] = *(const f32x4*)(ssq + (size_t)(r0 + ai * HALF + m * 16) * 16 + 4 * fq);
        __builtin_amdgcn_sched_barrier(0);
        float rsv[2][4];
#pragma unroll
        for (int ai = 0; ai < 2; ++ai)
#pragma unroll
            for (int m = 0; m < 4; ++m) rsv[ai][m] = rstd_of(pq[ai][m]);
        __builtin_amdgcn_sched_barrier(0);
#pragma unroll
        for (int ai = 0; ai < 2; ++ai)
#pragma unroll
            for (int m = 0; m < 4; ++m) {
                const int r = r0 + ai * HALF + m * 16;
                const int pos = (r < MREAL) ? (r & 127) : ((r + 112) & 127);
                const float sc = rsv[ai][m] * mul * __builtin_amdgcn_exp2f(sgn * (float)pos);
                const int cq = wc * 32 + 8 * fq;
                bf16_t* rowp = kind == 2 ? base + (size_t)r * ldc + col0 : base + ((size_t)(((r >> 5) * 4 + head) * 16 + (cq >> 4)) * 64 + ((cq >> 3) & 1) * 32 + (r & 31)) * 8;
                const int bjstep = kind == 2 ? HALF : 8 * 512;
#pragma unroll
                for (int bj = 0; bj < 2; ++bj) { const f32x4 v0 = acc[ai][bj][m][0] * sc, v1 = acc[ai][bj][m][1] * sc;
                    u32x4 w; w.x = pk2(v0[0], v0[1]); w.y = pk2(v0[2], v0[3]); w.z = pk2(v1[0], v1[1]); w.w = pk2(v1[2], v1[3]);
                    *(u32x4*)(rowp + bj * bjstep) = w; }
            }
    }
};
struct EpiG {
    static constexpr bool PERM = true, AFTER_DRAIN = false;
    bf16_t* VO; const bf16_t* Ometa; const float* ssq; const float* stats;
    __device__ __forceinline__ void operator()(const f32x4 (&acc)[2][2][4][2], const Unit& u, int wr, int wc, int fr, int fq) const {
        const int head = u.pn >> 1, col0 = u.pn * 256 + wc * 32 + 8 * fq;
        const int r0 = u.pm * BM + wr * 64 + fr;
#pragma unroll
        for (int ai = 0; ai < 2; ++ai) {
            f32x4 pq[4], sa[4], sb[4]; u32x4 ov[4][2];
#pragma unroll
            for (int m = 0; m < 4; ++m) { const int r = r0 + ai * HALF + m * 16;
                pq[m] = *(const f32x4*)(ssq + (size_t)r * 16 + 4 * fq);
                const f32x4* sp = (const f32x4*)(stats + ((size_t)r * 4 + head) * 32) + 2 * fq; sa[m] = sp[0]; sb[m] = sp[1];
                const bf16_t* orow = (r < MREAL ? VO + (size_t)r * 2048 : Ometa + (size_t)(r - MREAL) * 2048) + col0;
                ov[m][0] = *(const u32x4*)orow; ov[m][1] = *(const u32x4*)(orow + HALF); }
            __builtin_amdgcn_sched_barrier(0);
            float rsv[4], s1v[4], s2v[4];
#pragma unroll
            for (int m = 0; m < 4; ++m) { rsv[m] = rstd_of(pq[m]); s1v[m] = xsum_row4((sa[m].x + sa[m].z) + (sb[m].x + sb[m].z)); s2v[m] = xsum_row4((sa[m].y + sa[m].w) + (sb[m].y + sb[m].w)); }
            __builtin_amdgcn_sched_barrier(0);
#pragma unroll
            for (int m = 0; m < 4; ++m) { const int r = r0 + ai * HALF + m * 16;
                const float rstd = rsv[m];
                const float s1 = s1v[m], s2 = s2v[m];
                const float mu = s1 * (1.f / 512.f); float var = s2 * (1.f / 512.f) - mu * mu; var = var > 0.f ? var : 0.f;
                const float rs = rsqrtf(var + 1e-6f);
                bf16_t* wrow = VO + (size_t)r * 2048 + col0;
#pragma unroll
                for (int bj = 0; bj < 2; ++bj) { const u32x4 o4 = ov[m][bj];
                    const f32x4 g0 = acc[ai][bj][m][0] * rstd, g1 = acc[ai][bj][m][1] * rstd;
                    u32x4 w;
                    w.x = pk2(siluf(g0[0]) * (bflo(o4.x) - mu) * rs, siluf(g0[1]) * (bfhi(o4.x) - mu) * rs);
                    w.y = pk2(siluf(g0[2]) * (bflo(o4.y) - mu) * rs, siluf(g0[3]) * (bfhi(o4.y) - mu) * rs);
                    w.z = pk2(siluf(g1[0]) * (bflo(o4.z) - mu) * rs, siluf(g1[1]) * (bfhi(o4.z) - mu) * rs);
                    w.w = pk2(siluf(g1[2]) * (bflo(o4.w) - mu) * rs, siluf(g1[3]) * (bfhi(o4.w) - mu) * rs);
                    *(u32x4*)(wrow + bj * HALF) = w; }
            }
        }
    }
};
struct EpiRes {
    static constexpr bool PERM = true, AFTER_DRAIN = false;
    bf16_t* HB; float* ssq;
    __device__ __forceinline__ void operator()(const f32x4 (&acc)[2][2][4][2], const Unit& u, int wr, int wc, int fr, int fq) const {
        const int col0 = u.pn * BM + wc * 32 + 8 * fq;
        const int r0 = u.pm * BM + wr * 64 + fr;
        float ssv[2][4];
        u32x4 ov[2][4][2];
#pragma unroll
        for (int ai = 0; ai < 2; ++ai)
#pragma unroll
            for (int m = 0; m < 4; ++m) { const bf16_t* brow = HB + (size_t)(r0 + ai * HALF + m * 16) * DM + col0; ov[ai][m][0] = *(const u32x4*)brow; ov[ai][m][1] = *(const u32x4*)(brow + HALF); }
        __builtin_amdgcn_sched_barrier(0);
#pragma unroll
        for (int ai = 0; ai < 2; ++ai)
#pragma unroll
            for (int m = 0; m < 4; ++m) {
                const int r = r0 + ai * HALF + m * 16;
                bf16_t* brow = HB + (size_t)r * DM + col0;
                float ss = 0.f;
#pragma unroll
                for (int bj = 0; bj < 2; ++bj) { const u32x4 o4 = ov[ai][m][bj]; const f32x4 a0 = acc[ai][bj][m][0], a1 = acc[ai][bj][m][1];
                    u32x4 w; w.x = pk2(bflo(o4.x) + a0[0], bfhi(o4.x) + a0[1]); w.y = pk2(bflo(o4.y) + a0[2], bfhi(o4.y) + a0[3]);
                    w.z = pk2(bflo(o4.z) + a1[0], bfhi(o4.z) + a1[1]); w.w = pk2(bflo(o4.w) + a1[2], bfhi(o4.w) + a1[3]);
                    *(u32x4*)(brow + bj * HALF) = w;
                    ss += (bflo(w.x) * bflo(w.x) + bfhi(w.x) * bfhi(w.x)) + (bflo(w.y) * bflo(w.y) + bfhi(w.y) * bfhi(w.y)) + (bflo(w.z) * bflo(w.z) + bfhi(w.z) * bfhi(w.z)) + (bflo(w.w) * bflo(w.w) + bfhi(w.w) * bfhi(w.w)); }
                ssv[ai][m] = ss;
            }
#pragma unroll
        for (int ai = 0; ai < 2; ++ai)
#pragma unroll
            for (int m = 0; m < 4; ++m) ssv[ai][m] = xsum_row4(ssv[ai][m]);
        if (fq == 0) {
#pragma unroll
            for (int ai = 0; ai < 2; ++ai)
#pragma unroll
                for (int m = 0; m < 4; ++m) ssq[(size_t)(r0 + ai * HALF + m * 16) * 16 + u.pn * 4 + wc] = ssv[ai][m];
        }
    }
};
struct EpiFfnIn {
    static constexpr bool PERM = true, AFTER_DRAIN = false;
    bf16_t* ACT; const float* ssq;
    __device__ __forceinline__ void operator()(const f32x4 (&acc)[2][2][4][2], const Unit& u, int wr, int wc, int fr, int fq) const {
        const int col0 = u.pn * 128 + wc * 32 + 8 * fq;
        const int r0 = u.pm * BM + wr * 64 + fr;
        f32x4 pq[2][4];
#pragma unroll
        for (int ai = 0; ai < 2; ++ai)
#pragma unroll
            for (int m = 0; m < 4; ++m) pq[ai][m] = *(const f32x4*)(ssq + (size_t)(r0 + ai * HALF + m * 16) * 16 + 4 * fq);
        __builtin_amdgcn_sched_barrier(0);
        float rsv[2][4];
#pragma unroll
        for (int ai = 0; ai < 2; ++ai)
#pragma unroll
            for (int m = 0; m < 4; ++m) rsv[ai][m] = rstd_of(pq[ai][m]);
        __builtin_amdgcn_sched_barrier(0);
#pragma unroll
        for (int ai = 0; ai < 2; ++ai)
#pragma unroll
            for (int m = 0; m < 4; ++m) {
                const int r = r0 + ai * HALF + m * 16;
                const float rstd = rsv[ai][m];
                const f32x4 g0 = acc[ai][0][m][0] * rstd, g1 = acc[ai][0][m][1] * rstd, u0 = acc[ai][1][m][0] * rstd, u1 = acc[ai][1][m][1] * rstd;
                const f32x4 e0 = g0 * -1.4426950408889634f, e1 = g1 * -1.4426950408889634f;
                f32x4 x0, x1;
#pragma unroll
                for (int q = 0; q < 4; ++q) { x0[q] = __builtin_amdgcn_exp2f(e0[q]); x1[q] = __builtin_amdgcn_exp2f(e1[q]); }
                x0 = x0 + 1.f; x1 = x1 + 1.f;
                f32x4 r0, r1;
#pragma unroll
                for (int q = 0; q < 4; ++q) { r0[q] = __builtin_amdgcn_rcpf(x0[q]); r1[q] = __builtin_amdgcn_rcpf(x1[q]); }
                const f32x4 y0 = (g0 * u0) * r0, y1 = (g1 * u1) * r1;
                u32x4 w; w.x = pk2(y0[0], y0[1]); w.y = pk2(y0[2], y0[3]); w.z = pk2(y1[0], y1[1]); w.w = pk2(y1[2], y1[3]);
                *(u32x4*)(ACT + (size_t)r * FFH + col0) = w;
            }
    }
};
struct EpiQKV {
    static constexpr bool PERM = true, AFTER_DRAIN = false;
    bf16_t *Qs, *KV; const float* ssq;
    __device__ __forceinline__ void operator()(const f32x4 (&acc)[2][2][4][2], const Unit& u, int wr, int wc, int fr, int fq) const {
        const bool isq = u.pn < 4; bf16_t* base = isq ? Qs : KV; const int ldc = isq ? 1024 : 512;
        const int col0 = (isq ? u.pn : u.pn - 4) * 256 + wc * 32 + 8 * fq; const float s0 = isq ? 0.125f * 1.4426950408889634f : 1.f;
        const int r0 = u.pm * BM + wr * 64 + fr;
        f32x4 pq[2][4];
#pragma unroll
        for (int ai = 0; ai < 2; ++ai)
#pragma unroll
            for (int m = 0; m < 4; ++m) pq[ai][m] = *(const f32x4*)(ssq + (size_t)(r0 + ai * HALF + m * 16) * 16 + 4 * fq);
        __builtin_amdgcn_sched_barrier(0);
        float rsv[2][4];
#pragma unroll
        for (int ai = 0; ai < 2; ++ai)
#pragma unroll
            for (int m = 0; m < 4; ++m) rsv[ai][m] = rstd_of(pq[ai][m]);
        __builtin_amdgcn_sched_barrier(0);
#pragma unroll
        for (int ai = 0; ai < 2; ++ai)
#pragma unroll
            for (int m = 0; m < 4; ++m) {
                const int r = r0 + ai * HALF + m * 16;
                const float sc = rsv[ai][m] * s0;
                bf16_t* rowp = base + (size_t)r * ldc + col0;
#pragma unroll
                for (int bj = 0; bj < 2; ++bj) { const f32x4 v0 = acc[ai][bj][m][0] * sc, v1 = acc[ai][bj][m][1] * sc;
                    u32x4 w; w.x = pk2(v0[0], v0[1]); w.y = pk2(v0[2], v0[3]); w.z = pk2(v1[0], v1[1]); w.w = pk2(v1[2], v1[3]);
                    *(u32x4*)(rowp + bj * HALF) = w; }
            }
    }
};
}

DI float wave_sum(float v) {
#pragma unroll
    for (int o = 1; o < 64; o <<= 1) v += __shfl_xor(v, o);
    return v;
}
struct TItem { const float* W; bf16_t* WT; const float* gain; int K, N, row_off, mode, item; };
DI void t_load(const TItem& d, int lane, f32x4 (&wv)[8]) {
    const int nblk = d.N / 32, kb = d.item / nblk, nb = d.item % nblk, k0 = 64 * kb, n0 = 32 * nb;
#pragma unroll
    for (int i = 0; i < 8; ++i) wv[i] = *(const f32x4*)(d.W + (size_t)(k0 + 8 * i + (lane >> 3)) * d.N + n0 + 4 * (lane & 7));
}
DI void t_finish(const TItem& d, const f32x4 (&wv)[8], LAS float* scr, int lane) {
    const int nblk = d.N / 32, kb = d.item / nblk, nb = d.item % nblk, k0 = 64 * kb, n0 = 32 * nb;
#pragma unroll
    for (int i = 0; i < 8; ++i) { const int kk = 8 * i + (lane >> 3); const float gsc = d.gain ? d.gain[k0 + kk] : 1.f; LAS float* p = scr + kk * 33 + 4 * (lane & 7);
        p[0] = wv[i].x * gsc; p[1] = wv[i].y * gsc; p[2] = wv[i].z * gsc; p[3] = wv[i].w * gsc; }
    asm volatile("s_waitcnt lgkmcnt(0)" ::: "memory");
    int row0 = d.row_off + n0;
    if (d.mode == 1) row0 = d.row_off + (n0 < FFH ? 256 * (n0 >> 7) + (n0 & 127) : 256 * ((n0 - FFH) >> 7) + 128 + ((n0 - FFH) & 127));
    const int c = lane & 7;
#pragma unroll
    for (int j = 0; j < 4; ++j) { const int n = (lane >> 3) + 8 * j; const LAS float* q = scr + (8 * c) * 33 + n;
        u32x4 o; o.x = pk2(q[0 * 33], q[1 * 33]); o.y = pk2(q[2 * 33], q[3 * 33]); o.z = pk2(q[4 * 33], q[5 * 33]); o.w = pk2(q[6 * 33], q[7 * 33]);
        *(u32x4*)(d.WT + (size_t)(row0 + n) * d.K + k0 + 8 * c) = o; }
    asm volatile("s_waitcnt lgkmcnt(0)" ::: "memory");
}

struct Args { const float* in[14]; float* out; unsigned char* ws; int nseq; unsigned char seq[124]; };

DI void prologue(LAS unsigned char* lds, int gw, int NGW, int wave, int lane) {
    unsigned char* const ws_ = KWS;
    LAS float* scr = (LAS float*)(lds + wave * 16384);
    bf16_t* WT = (bf16_t*)(ws_ + WS_WT);
    const float *mixn = KIN(2), *ffnn = KIN(3), *rwin = KIN(4), *rwout = KIN(5), *kvn = KIN(6), *kvw = KIN(7), *wq = KIN(8), *wo = KIN(9), *fwi = KIN(11), *fwo = KIN(12);
    constexpr int I_WIN = 16 * 192, I_WOUT = 32 * 32, I_FFI = 16 * 176, I_FFO = 44 * 32, I_Q = 16 * 32, I_KV = 16 * 16;
    constexpr int NITEMS = 2 * I_WIN + 2 * I_WOUT + 4 * I_FFI + 4 * I_FFO + 2 * I_Q + I_KV + 2 * I_Q;
#define T_DECODE(it_, d_) do { int r_ = (it_); \
        if (r_ < 2 * I_WIN) { const int l_ = r_ / I_WIN; d_ = TItem{rwin + (size_t)l_ * 1024 * 6144, WT + WO_WIN + (size_t)l_ * 6291456, mixn + l_ * 1024, 1024, 6144, 0, 0, r_ % I_WIN}; break; } r_ -= 2 * I_WIN; \
        if (r_ < 2 * I_WOUT) { const int l_ = r_ / I_WOUT; d_ = TItem{rwout + (size_t)l_ * 2048 * 1024, WT + WO_WOUT + (size_t)l_ * 2097152, nullptr, 2048, 1024, 0, 0, r_ % I_WOUT}; break; } r_ -= 2 * I_WOUT; \
        if (r_ < 4 * I_FFI) { const int l_ = r_ / I_FFI; d_ = TItem{fwi + (size_t)l_ * 1024 * 5632, WT + WO_FFI + (size_t)l_ * 5767168, ffnn + l_ * 1024, 1024, 5632, 0, 1, r_ % I_FFI}; break; } r_ -= 4 * I_FFI; \
        if (r_ < 4 * I_FFO) { const int l_ = r_ / I_FFO; d_ = TItem{fwo + (size_t)l_ * 2816 * 1024, WT + WO_FFO + (size_t)l_ * 2883584, nullptr, 2816, 1024, 0, 0, r_ % I_FFO}; break; } r_ -= 4 * I_FFO; \
        if (r_ < I_Q) { d_ = TItem{wq, WT + WO_QKV2, mixn + 2 * 1024, 1024, 1024, 0, 0, r_}; break; } r_ -= I_Q; \
        if (r_ < I_KV) { d_ = TItem{kvw, WT + WO_QKV2, kvn, 1024, 512, 1024, 0, r_}; break; } r_ -= I_KV; \
        if (r_ < I_Q) { d_ = TItem{wq + (size_t)1024 * 1024, WT + WO_Q3, mixn + 3 * 1024, 1024, 1024, 0, 0, r_}; break; } r_ -= I_Q; \
        { const int l_ = r_ / I_Q; d_ = TItem{wo + (size_t)l_ * 1024 * 1024, WT + WO_WO + (size_t)l_ * 1048576, nullptr, 1024, 1024, 0, 0, r_ % I_Q}; } } while (0)
    {
        int it = gw; TItem cur{}; f32x4 wc[8];
        if (it < NITEMS) { T_DECODE(it, cur); t_load(cur, lane, wc); }
        while (it < NITEMS) {
            const int nx = it + NGW; TItem nd{}; f32x4 wn[8];
            if (nx < NITEMS) { T_DECODE(nx, nd); t_load(nd, lane, wn); }
            t_finish(cur, wc, scr, lane);
            cur = nd;
#pragma unroll
            for (int i = 0; i < 8; ++i) wc[i] = wn[i];
            it = nx;
        }
    }
#undef T_DECODE
    const float* x = KIN(0); const float* meta = KIN(1);
    bf16_t* HB = (bf16_t*)(ws_ + WS_HB); float* ssq = (float*)(ws_ + WS_SSQ);
    for (int m = gw; m < MREAL + 32; m += NGW) {
        u32x2 v[4]; float s = 0.f;
        const bool real = m < MREAL, ismeta = !real && (m - MREAL) < 16;
        const f32x4* src = (const f32x4*)(real ? x + (size_t)m * DM : meta + (size_t)(ismeta ? m - MREAL : 0) * DM) + lane;
#pragma unroll
        for (int j = 0; j < 4; ++j) { const f32x4 t = (real || ismeta) ? src[64 * j] : (f32x4){0.f, 0.f, 0.f, 0.f}; v[j].x = pk2(t.x, t.y); v[j].y = pk2(t.z, t.w);
            s += (bflo(v[j].x) * bflo(v[j].x) + bfhi(v[j].x) * bfhi(v[j].x)) + (bflo(v[j].y) * bflo(v[j].y) + bfhi(v[j].y) * bfhi(v[j].y)); }
        s = wave_sum(s);
        u32x2* o8 = (u32x2*)(HB + (size_t)m * DM) + lane;
#pragma unroll
        for (int j = 0; j < 4; ++j) o8[64 * j] = v[j];
        if (lane < 16) ssq[(size_t)m * 16 + lane] = lane == 0 ? s : 0.f;
    }
}

DI void final_norm(int gw, int NGW, int lane) {
    unsigned char* const ws_ = KWS;
    const float* ssq = (const float*)(ws_ + WS_SSQ); const f32x4* gn = (const f32x4*)KIN(13) + lane; float* const out_ = KOUT; const bf16_t* HB = (const bf16_t*)(ws_ + WS_HB);
    for (int m = gw; m < MREAL; m += NGW) {
        const float rstd = row_rstd(ssq, m);
        f32x4* p = (f32x4*)(out_ + (size_t)m * DM) + lane; const u32x2* hb = (const u32x2*)(HB + (size_t)m * DM) + lane;
#pragma unroll
        for (int j = 0; j < 4; ++j) { const u32x2 h = hb[64 * j]; const f32x4 g = gn[64 * j];
            p[64 * j] = (f32x4){bflo(h.x) * rstd * g.x, bfhi(h.x) * rstd * g.y, bflo(h.y) * rstd * g.z, bfhi(h.y) * rstd * g.w}; }
    }
}

DI size_t ret_row(int b, int n, int s) { return n == 0 ? (size_t)(s >= 112 ? MREAL + s - 112 : MREAL + 16 + (s & 15)) : (size_t)(b * 4096 + (n - 1) * 128 + s); }
DI size_t frag_off(int b, int n, int t, int h, int r, int hh) {
    int tile, rr;
    if (n == 0) { tile = 1024; rr = (t == 3) ? ((r + 16) & 31) : (16 + (r & 15)); } else { tile = b * 128 + (n - 1) * 4 + t; rr = r; }
    return ((size_t)((tile * 4 + h) * 16) * 64 + hh * 32 + rr) * 8;
}
DI bf16x8 trfrag(LAS const unsigned char* p, int rowstride4) {
    const v4i16_t lo = __builtin_amdgcn_ds_read_tr16_b64_v4i16((LAS v4i16_t*)p);
    const v4i16_t hi = __builtin_amdgcn_ds_read_tr16_b64_v4i16((LAS v4i16_t*)(p + rowstride4));
    return __builtin_shufflevector(lo, hi, 0, 1, 2, 3, 4, 5, 6, 7);
}
#define LDS_BARRIER() asm volatile("s_waitcnt lgkmcnt(0)\n\ts_barrier" ::: "memory")
DI void p_phase(LAS unsigned char* lds, const bf16_t* Q, const bf16_t* K, bf16_t* P, bf16_t* KT, int vcu, int G, int w, int lane) {
    constexpr int KRS = 544;
    const int r = lane & 31, hh = lane >> 5, jc = w >> 1, i16 = lane & 15, q4 = i16 >> 2, p4 = i16 & 3, blk = (lane >> 4) & 1;
    const unsigned k_tr = (8 * hh + q4) * KRS + (32 * w + 16 * blk + 4 * p4) * 2;
    const unsigned k_st = r * KRS + hh * 16 + w * 32;
    const int st0 = w & 1, st1 = st0 + 2; const bool has0 = st0 <= jc, has1 = st1 <= jc;
#define P_DECODE(it_, b_, h_, n_) do { if ((it_) < 1024) { b_ = (it_) >> 7; h_ = ((it_) >> 5) & 3; n_ = 1 + ((it_) & 31); } else { b_ = 0; h_ = (it_) - 1024; n_ = 0; } } while (0)
#define P_PREFETCH(it_) do { int b_, h_, n_; P_DECODE(it_, b_, h_, n_); \
        const bool l0_ = has0 && (n_ > 0 || (st0 == 3 && jc == 3)), l1_ = has1 && (n_ > 0 || (st1 == 3 && jc == 3)); \
        _Pragma("unroll") for (int i = 0; i < 8; ++i) kv[i] = *(const u32x4*)(K + frag_off(b_, n_, i >> 1, h_, r, hh) + (size_t)((i & 1) * 8 + w) * 512); \
        const bf16_t* qa_ = Q + frag_off(b_, n_, jc, h_, r, hh); const bf16_t* ka0_ = K + frag_off(b_, n_, st0, h_, r, hh); const bf16_t* ka1_ = K + frag_off(b_, n_, has1 ? st1 : st0, h_, r, hh); \
        if (l0_ || l1_) { _Pragma("unroll") for (int ks = 0; ks < 8; ++ks) { qf[ks] = *(const bf16x8*)(qa_ + 512 * ks); if (l0_) a0[ks] = *(const bf16x8*)(ka0_ + 512 * ks); if (l1_) a1[ks] = *(const bf16x8*)(ka1_ + 512 * ks); } } } while (0)
    u32x4 kv[8]; bf16x8 qf[8], a0[8], a1[8];
    int it = vcu;
    if (it < 1028) P_PREFETCH(it);
    while (it < 1028) {
        int b, h, n; P_DECODE(it, b, h, n);
        const size_t item = (size_t)((b * 4 + h) * 33 + n);
        bf16_t* Pit = P + item * 16384;
        const bool live0 = has0 && (n > 0 || (st0 == 3 && jc == 3)), live1 = has1 && (n > 0 || (st1 == 3 && jc == 3));
        f32x16 acc0, acc1; for (int i = 0; i < 16; ++i) { acc0[i] = 0.f; acc1[i] = 0.f; }
        if (live0 || live1) {
#pragma unroll
            for (int ks = 0; ks < 8; ++ks) { if (live0) acc0 = MFMA32(a0[ks], qf[ks], acc0); if (live1) acc1 = MFMA32(a1[ks], qf[ks], acc1); }
            const bf16_t* qa = Q + frag_off(b, n, jc, h, r, hh) + 512 * 8; const bf16_t* ka0 = K + frag_off(b, n, st0, h, r, hh) + 512 * 8; const bf16_t* ka1 = K + frag_off(b, n, has1 ? st1 : st0, h, r, hh) + 512 * 8;
#pragma unroll
            for (int ks = 0; ks < 8; ++ks) { qf[ks] = *(const bf16x8*)(qa + 512 * ks); if (live0) a0[ks] = *(const bf16x8*)(ka0 + 512 * ks); if (live1) a1[ks] = *(const bf16x8*)(ka1 + 512 * ks); }
#pragma unroll
            for (int ks = 0; ks < 8; ++ks) { if (live0) acc0 = MFMA32(a0[ks], qf[ks], acc0); if (live1) acc1 = MFMA32(a1[ks], qf[ks], acc1); }
        }
#pragma unroll
        for (int i = 0; i < 8; ++i) *(LAS u32x4*)(lds + k_st + (i >> 1) * 32 * KRS + (i & 1) * 256) = kv[i];
        LDS_BARRIER();
        bf16x8 kf[8];
#pragma unroll
        for (int ks = 0; ks < 8; ++ks) kf[ks] = trfrag(lds + k_tr + ks * 16 * KRS, 4 * KRS);
        const int nx = it + G;
        if (nx < 1028) P_PREFETCH(nx);
        __builtin_amdgcn_sched_barrier(0);
        const int c = 32 * jc + r;
#pragma unroll
        for (int tl = 0; tl < 2; ++tl) { const int st = tl ? st1 : st0; const f32x16 acc = tl ? acc1 : acc0;
            if (tl ? has1 : has0) {
#pragma unroll
                for (int g = 0; g < 4; ++g) { const int s0 = 32 * st + 8 * g + 4 * hh;
                    const float v0 = (s0 + 0 <= c) ? acc[4 * g + 0] : 0.f, v1 = (s0 + 1 <= c) ? acc[4 * g + 1] : 0.f, v2 = (s0 + 2 <= c) ? acc[4 * g + 2] : 0.f, v3 = (s0 + 3 <= c) ? acc[4 * g + 3] : 0.f;
                    u32x2 wv; wv.x = pk2(v0, v1); wv.y = pk2(v2, v3);
                    *(u32x2*)(Pit + ((size_t)((jc * 8 + 2 * st + (g >> 1)) * 64) + (g & 1) * 32 + r) * 8 + 4 * hh) = wv; }
            }
        }
        bf16_t* kt = KT + ((item * 8 + w) * 8) * 512 + (size_t)lane * 8;
#pragma unroll
        for (int ks = 0; ks < 8; ++ks) *(bf16x8*)(kt + 512 * ks) = kf[ks];
        LDS_BARRIER();
        it = nx;
    }
#undef P_DECODE
#undef P_PREFETCH
}
template <bool OROLE>
DI void scan_role(LAS unsigned char* lds, const bf16_t* Q, const bf16_t* KT, bf16_t* VO, bf16_t* Ometa, const bf16_t* P, float* stats, int vcu, int G, int tid, int lane, int w) {
    constexpr int VRS = 160, SRS = 528, VS_OFF = 0, VS_SZ = 128 * VRS, ST_OFF = VS_OFF + 2 * VS_SZ, ST_SZ = 64 * SRS;
    static_assert(ST_OFF + 2 * ST_SZ <= 131072, "scan LDS");
    const int r = lane & 31, hh = lane >> 5, i16 = lane & 15, q4 = i16 >> 2, p4 = i16 & 3, blk = (lane >> 4) & 1;
    const int jc = w & 3, nks = 2 * jc + 2;
    const unsigned v_tr = VS_OFF + (8 * hh + q4) * VRS + (16 * blk + 4 * p4) * 2;
    const unsigned s_rd = ST_OFF + r * SRS + 16 * hh;
    const unsigned s_wr = ST_OFF + r * SRS + (64 * jc + 4 * hh) * 2;
    const unsigned v_st = VS_OFF + (tid >> 3) * VRS + (tid & 7) * 16;
    const unsigned lp_reg = (unsigned)lane * 8u;
    for (int it = vcu; it < 256; it += G) {
        const int b = it >> 5, h = (it >> 3) & 3, j = it & 7;
        const float l2g = head_l2g(h), gam = 1.f - __builtin_amdgcn_exp2f(-5.f - (float)h), gC1 = __builtin_amdgcn_exp2f(127.f * l2g);
        f32x16 z16; for (int i = 0; i < 16; ++i) z16[i] = 0.f;
        f32x16 acc[OROLE ? 2 : 4];
#pragma unroll
        for (int t = 0; t < (OROLE ? 2 : 4); ++t) acc[t] = z16;
        const bf16_t* vb = VO + h * 512 + 64 * j + (tid & 7) * 8;
#define SC_ITEM(n_) ((size_t)((((n_) == 0 ? 0 : b) * 4 + h) * 33 + (n_)))
#define SC_KT(n_) (KT + ((SC_ITEM(n_) * 8 + 2 * jc) * 8) * 512 + lp_reg)
#define SC_P(n_) (P + SC_ITEM(n_) * 16384 + (size_t)(jc * 8 * 64) * 8 + lp_reg)
#define SC_Q(n_) (Q + ((size_t)((b * 128 + ((n_) - 1) * 4 + jc) * 4 + h) * 16) * 512 + lp_reg)
        bf16x8 fr[OROLE ? 24 : 16]; u32x4 vv[2];
#pragma unroll
        for (int i = 0; i < 2; ++i) vv[i] = *(const u32x4*)(vb + ret_row(b, 0, (tid >> 3) + 64 * i) * 2048);
        if constexpr (OROLE) { const bf16_t* pa = SC_P(0);
#pragma unroll
            for (int ks = 0; ks < 8; ++ks) if (ks < nks) fr[16 + ks] = *(const bf16x8*)(pa + 512 * ks);
        } else { const bf16_t* kt = SC_KT(0);
#pragma unroll
            for (int ks = 0; ks < 16; ++ks) fr[ks] = *(const bf16x8*)(kt + 512 * ks); }
#pragma unroll
        for (int i = 0; i < 2; ++i) *(LAS u32x4*)(lds + v_st + i * 64 * VRS) = vv[i];
        { int t3 = tid >> 3; asm volatile("" : "+v"(t3));
#pragma unroll
          for (int i = 0; i < 2; ++i) vv[i] = *(const u32x4*)(vb + ret_row(b, 1, t3 + 64 * i) * 2048); }
        LDS_BARRIER();
        for (int n = 0; n < 33; ++n) {
            const bool more = n < 32;
            const unsigned cv = (unsigned)(n & 1) * VS_SZ, nv = VS_SZ - cv, cs = (unsigned)(n & 1) * ST_SZ, ns = ST_SZ - cs;
            if constexpr (OROLE) {
                const bf16_t* pan = SC_P(n + 1); const bf16_t* qan = SC_Q(n + 1);
                acc[0] = z16; acc[1] = z16;
#pragma unroll
                for (int ks = 0; ks < 8; ++ks) if (ks < nks) {
                    const bf16x8 vf0 = trfrag(lds + v_tr + cv + ks * 16 * VRS, 4 * VRS);
                    const bf16x8 vf1 = trfrag(lds + v_tr + cv + ks * 16 * VRS + 64, 4 * VRS);
                    acc[0] = MFMA32(vf0, fr[16 + ks], acc[0]); acc[1] = MFMA32(vf1, fr[16 + ks], acc[1]);
                    if (more) fr[16 + ks] = *(const bf16x8*)(pan + 512 * ks);
                    __builtin_amdgcn_sched_barrier(0);
                }
                if (n > 0) {
#pragma unroll
                    for (int ks = 0; ks < 16; ++ks) { const bf16x8 a0 = *(const LAS bf16x8*)(lds + s_rd + cs + ks * 32); const bf16x8 a1 = *(const LAS bf16x8*)(lds + s_rd + cs + 32 * SRS + ks * 32);
                        acc[0] = MFMA32(a0, fr[ks], acc[0]); acc[1] = MFMA32(a1, fr[ks], acc[1]);
                        if (more) fr[ks] = *(const bf16x8*)(qan + 512 * ks);
                        if ((ks & 3) == 3) __builtin_amdgcn_sched_barrier(0); }
                } else {
#pragma unroll
                    for (int ks = 0; ks < 16; ++ks) fr[ks] = *(const bf16x8*)(qan + 512 * ks);
                }
                if (n > 0 || b == 0) {
                    int r_l = r; asm volatile("" : "+v"(r_l));
                    const size_t row = ret_row(b, n, 32 * jc + r_l);
                    bf16_t* dst = (n == 0 ? Ometa + (row - MREAL) * 2048 : VO + row * 2048) + h * 512 + 64 * j + 4 * hh;
                    float s1 = 0.f, s2 = 0.f;
#pragma unroll
                    for (int t = 0; t < 2; ++t)
#pragma unroll
                        for (int g = 0; g < 4; ++g) { const f32x16 o = acc[t]; u32x2 wv; wv.x = pk2(o[4 * g], o[4 * g + 1]); wv.y = pk2(o[4 * g + 2], o[4 * g + 3]); *(u32x2*)(dst + 32 * t + 8 * g) = wv;
                            s1 += (o[4 * g] + o[4 * g + 1]) + (o[4 * g + 2] + o[4 * g + 3]);
                            s2 += (o[4 * g] * o[4 * g] + o[4 * g + 1] * o[4 * g + 1]) + (o[4 * g + 2] * o[4 * g + 2] + o[4 * g + 3] * o[4 * g + 3]); }
                    s1 += __shfl_xor(s1, 32); s2 += __shfl_xor(s2, 32);
                    if (hh == 0) { const f32x4 sv = {s1, s2, 0.f, 0.f}; *(f32x4*)(stats + ((row * 4 + h) * 16 + 2 * j) * 2) = sv; }
                }
            } else {
                const bf16_t* ktn = SC_KT(n + 1);
#pragma unroll
                for (int t = 0; t < 4; ++t) acc[t] = acc[t] * gam;
#pragma unroll
                for (int ks = 0; ks < 8; ++ks) {
                    const bf16x8 vf0 = trfrag(lds + v_tr + cv + ks * 16 * VRS, 4 * VRS);
                    const bf16x8 vf1 = trfrag(lds + v_tr + cv + ks * 16 * VRS + 64, 4 * VRS);
                    acc[0] = MFMA32(fr[ks], vf0, acc[0]); acc[1] = MFMA32(fr[ks], vf1, acc[1]);
                    acc[2] = MFMA32(fr[8 + ks], vf0, acc[2]); acc[3] = MFMA32(fr[8 + ks], vf1, acc[3]);
                    if (more) { fr[ks] = *(const bf16x8*)(ktn + 512 * ks); fr[8 + ks] = *(const bf16x8*)(ktn + 512 * (8 + ks)); }
                    __builtin_amdgcn_sched_barrier(0);
                }
#pragma unroll
                for (int t = 0; t < 4; ++t) acc[t] = acc[t] * gC1;
            }
            if constexpr (!OROLE) {
#pragma unroll
                for (int t = 0; t < 4; ++t)
#pragma unroll
                    for (int g = 0; g < 4; ++g) { u32x2 a; a.x = pk2(acc[t][4 * g] * gam, acc[t][4 * g + 1] * gam); a.y = pk2(acc[t][4 * g + 2] * gam, acc[t][4 * g + 3] * gam);
                        *(LAS u32x2*)(lds + s_wr + ns + (t & 1) * 32 * SRS + (t >> 1) * 64 + g * 16) = a; }
            }
            if (more) {
#pragma unroll
                for (int i = 0; i < 2; ++i) *(LAS u32x4*)(lds + v_st + nv + i * 64 * VRS) = vv[i];
                if (n + 2 < 33) { int t3 = tid >> 3; asm volatile("" : "+v"(t3));
#pragma unroll
                    for (int i = 0; i < 2; ++i) vv[i] = *(const u32x4*)(vb + ret_row(b, n + 2, t3 + 64 * i) * 2048); }
            }
            LDS_BARRIER();
        }
#undef SC_ITEM
#undef SC_KT
#undef SC_P
#undef SC_Q
        LDS_BARRIER();
    }
}
DI void scan_phase(LAS unsigned char* lds, const bf16_t* Q, const bf16_t* KT, bf16_t* VO, bf16_t* Ometa, const bf16_t* P, float* stats, int vcu, int G) {
    int tid_s = threadIdx.x; asm volatile("" : "+v"(tid_s));
    const int tid = tid_s, lane = tid & 63, w = __builtin_amdgcn_readfirstlane(tid >> 6);
    if (w < 4) scan_role<true>(lds, Q, KT, VO, Ometa, P, stats, vcu, G, tid, lane, w);
    else scan_role<false>(lds, Q, KT, VO, Ometa, P, stats, vcu, G, tid, lane, w);
    asm volatile("s_waitcnt vmcnt(0)" ::: "memory");
}

template <bool FIRST>
DI void attn_task(LAS unsigned char* lds, const bf16_t* Qs, bf16_t* AO, float slope2, float sink2, size_t qrow, int head, int rb, int nb, int r, int hh, int q4, int p4, int blk) {
    constexpr int RS = 144, K_OFF = 0, V_OFF = 288 * RS;
    bf16x8 qf[4];
#pragma unroll
    for (int ks = 0; ks < 4; ++ks) qf[ks] = *(const bf16x8*)(Qs + qrow * 1024 + head * 64 + 16 * ks + 8 * hh);
    const int rq = 32 * rb + r, lim1 = FIRST ? rq : 127, D0 = 128 + r - 4 * hh;
    const float cst = slope2 * (float)(128 + r), h4 = slope2 * (float)(4 * hh), dm = slope2 * (float)(nb * 128 + 32 * rb - 112), sinkp = sink2 + cst;
#define ATT_TILE(t, st, init) do { const int rowbase_ = (t) == 0 ? 0 : 32 + 32 * (rb + (t) - 1); { const float in_ = (init); for (int i_ = 0; i_ < 16; ++i_) st[i_] = in_; } \
        int D0_ = D0; asm volatile("" : "+v"(D0_)); \
        _Pragma("unroll") for (int ks = 0; ks < 4; ++ks) { const bf16x8 a_ = *(const LAS bf16x8*)(lds + K_OFF + (rowbase_ + r) * RS + (16 * ks + 8 * hh) * 2); st = MFMA32(a_, qf[ks], st); } \
        _Pragma("unroll") for (int i_ = 0; i_ < 16; ++i_) { const int c_ = (i_ & 3) + 8 * (i_ >> 2); \
            if ((t) == 0) st[i_] = (i_ < 8) ? __builtin_fmaf(slope2, (float)c_, st[i_]) - dm : -INFINITY; \
            else { float v_ = __builtin_fmaf(slope2, (float)(32 * ((t) - 1) + c_), st[i_]); \
                if (FIRST || (t) == 1 || (t) == 5) { const int dist_ = D0_ - 32 * ((t) - 1) - c_; const unsigned bnd_ = ((unsigned)(dist_ | (lim1 - dist_)) & 0x80000000u) | 0x7f800000u; v_ = fminf(v_, __builtin_bit_cast(float, bnd_)); } \
                st[i_] = v_; } } } while (0)
    float m = sinkp, l = 0.f;
    f32x16 o0, o1; for (int i = 0; i < 16; ++i) { o0[i] = 0.f; o1[i] = 0.f; }
#pragma unroll
    for (int t = 0; t < 6; ++t) { const int rowbase = t == 0 ? 0 : 32 + 32 * (rb + t - 1);
        f32x16 st; ATT_TILE(t, st, h4);
        float tm = fmaxf(fmaxf(st[0], st[1]), fmaxf(st[2], st[3]));
#pragma unroll
        for (int i = 4; i < 16; i += 4) tm = fmaxf(tm, fmaxf(fmaxf(st[i], st[i + 1]), fmaxf(st[i + 2], st[i + 3])));
        tm = fmaxf(tm, __shfl_xor(tm, 32));
        const float mn = fmaxf(m, tm), sc = __builtin_amdgcn_exp2f(m - mn);
        m = mn;
        if (__any(sc != 1.f)) { l *= sc; o0 = o0 * sc; o1 = o1 * sc; }
#pragma unroll
        for (int i = 0; i < 16; ++i) { const float e = __builtin_amdgcn_exp2f(st[i] - mn); st[i] = e; l += e; }
#pragma unroll
        for (int ss = 0; ss < 2; ++ss) {
            u32x4 pw; pw.x = pk2(st[8 * ss], st[8 * ss + 1]); pw.y = pk2(st[8 * ss + 2], st[8 * ss + 3]);
            pw.z = pk2(st[8 * ss + 4], st[8 * ss + 5]); pw.w = pk2(st[8 * ss + 6], st[8 * ss + 7]);
            const bf16x8 pfrag = __builtin_bit_cast(bf16x8, pw);
            const int rowb = rowbase + 16 * ss + 4 * hh + q4;
            const bf16x8 a0 = trfrag(lds + V_OFF + rowb * RS + (16 * blk + 4 * p4) * 2, 8 * RS);
            const bf16x8 a1 = trfrag(lds + V_OFF + rowb * RS + (32 + 16 * blk + 4 * p4) * 2, 8 * RS);
            o0 = MFMA32(a0, pfrag, o0); o1 = MFMA32(a1, pfrag, o1);
        }
        __builtin_amdgcn_sched_barrier(0); }
#undef ATT_TILE
    float sum = l + __shfl_xor(l, 32); sum += __builtin_amdgcn_exp2f(sinkp - m);
    const float inv = 1.f / sum;
    o0 = o0 * inv; o1 = o1 * inv;
    bf16_t* dst = AO + qrow * 1024 + head * 64 + 4 * hh;
#pragma unroll
    for (int g4 = 0; g4 < 4; ++g4) { u32x2 a; a.x = pk2(o0[4 * g4], o0[4 * g4 + 1]); a.y = pk2(o0[4 * g4 + 2], o0[4 * g4 + 3]); *(u32x2*)(dst + 8 * g4) = a;
        u32x2 c; c.x = pk2(o1[4 * g4], o1[4 * g4 + 1]); c.y = pk2(o1[4 * g4 + 2], o1[4 * g4 + 3]); *(u32x2*)(dst + 32 + 8 * g4) = c; }
}
DI void attn_phase(LAS unsigned char* lds, const bf16_t* Qs, const bf16_t* KV, bf16_t* AO, const float* sinks, int vcu, int G, int w, int lane, int tid) {
    constexpr int RS = 144, K_OFF = 0, V_OFF = 288 * RS;
    constexpr float LOG2E = 1.4426950408889634f;
    const int r = lane & 31, hh = lane >> 5, i16 = lane & 15, q4 = i16 >> 2, p4 = i16 & 3, blk = (lane >> 4) & 1;
    for (int un = vcu; un < 1024; un += G) {
        const int b = un >> 7, kvh = (un >> 5) & 3, nb = un & 31;
        __syncthreads();
        for (int idx = tid; idx < 2304; idx += 512) { const int row = idx >> 3, ch = idx & 7;
            size_t grow; if (row < 32) grow = (size_t)MREAL + row; else { const int c = row - 32, t = nb * 128 - 128 + c; grow = t < 0 ? (size_t)(MREAL + 16 + (c & 15)) : (size_t)(b * 4096 + t); }
            const u32x4 kk = *(const u32x4*)(KV + grow * 512 + kvh * 64 + ch * 8), vv = *(const u32x4*)(KV + grow * 512 + 256 + kvh * 64 + ch * 8);
            *(LAS u32x4*)(lds + K_OFF + row * RS + ch * 16) = kk; *(LAS u32x4*)(lds + V_OFF + row * RS + ch * 16) = vv; }
        __syncthreads();
#pragma unroll 1
        for (int tt = 0; tt < 2; ++tt) {
            const int task = w * 2 + tt, g = task >> 2, rb = task & 3, head = kvh * 4 + g;
            const float slope2 = exp2f(-0.5f * (float)(head + 1)) * LOG2E, sink2 = sinks[head] * LOG2E;
            const size_t qrow = (size_t)b * 4096 + nb * 128 + 32 * rb + r;
            if (nb == 0) attn_task<true>(lds, Qs, AO, slope2, sink2, qrow, head, rb, nb, r, hh, q4, p4, blk);
            else attn_task<false>(lds, Qs, AO, slope2, sink2, qrow, head, rb, nb, r, hh, q4, p4, blk);
        }
    }
}


DI void skinny_phase(LAS unsigned char* lds, int kind, const bf16_t* A, const bf16_t* Bt, int K, unsigned char* ws, int vcu, int G, int w, int lane) {
    const int r = lane & 31, hh = lane >> 5;
    const int ntask = kind == 1 ? 128 : (kind == 4 ? 64 : (kind == 5 ? 16 : (kind == 6 ? 88 : 16)));
    const float* ssq = (const float*)(ws + WS_SSQ);
    LAS float* red = (LAS float*)lds;
    for (int task = vcu; task < ntask; task += G) {
        int nb0, nb1;
        if (kind == 5) { nb0 = 64 * task; nb1 = nb0 + 32; }
        else if (kind == 6) { nb0 = 256 * (task >> 2) + 32 * (task & 3); nb1 = nb0 + 128; }
        else if (kind == 7) { nb0 = 1024 + 32 * task; nb1 = nb0; }
        else { nb0 = 32 * task; nb1 = nb0; }
        const bool two = (kind == 5 || kind == 6);
        const int nks = K >> 7;
        const bf16_t* pa0 = Bt + (size_t)(nb0 + r) * K + w * (K >> 3) + 8 * hh;
        const bf16_t* pa1 = Bt + (size_t)(nb1 + r) * K + w * (K >> 3) + 8 * hh;
        const bf16_t* pb = A + (size_t)(MREAL + r) * K + w * (K >> 3) + 8 * hh;
        f32x16 acc0, acc1; for (int i = 0; i < 16; ++i) { acc0[i] = 0.f; acc1[i] = 0.f; }
#pragma unroll 8
        for (int ks = 0; ks < nks; ++ks) { const bf16x8 bx = *(const bf16x8*)(pb + 16 * ks); const bf16x8 a0 = *(const bf16x8*)(pa0 + 16 * ks); acc0 = MFMA32(a0, bx, acc0);
            if (two) { const bf16x8 a1 = *(const bf16x8*)(pa1 + 16 * ks); acc1 = MFMA32(a1, bx, acc1); } }
#pragma unroll
        for (int i = 0; i < 16; ++i) { red[((w * 2 + 0) * 16 + i) * 64 + lane] = acc0[i]; red[((w * 2 + 1) * 16 + i) * 64 + lane] = acc1[i]; }
        __syncthreads();
        if (w == 0) {
#pragma unroll
            for (int i = 0; i < 16; ++i) { float s0 = 0.f, s1 = 0.f;
#pragma unroll
                for (int ww = 0; ww < 8; ++ww) { s0 += red[((ww * 2 + 0) * 16 + i) * 64 + lane]; s1 += red[((ww * 2 + 1) * 16 + i) * 64 + lane]; }
                acc0[i] = s0; acc1[i] = s1; }
            const int row = MREAL + r; const float rstd = row_rstd(ssq, row);
            if (kind == 1) {
                const int pn = nb0 >> 8, kd = pn < 4 ? 0 : (pn < 8 ? 1 : 2), head = pn & 3;
                const float l2g = head_l2g(head), sgn = kd == 0 ? l2g : (kd == 1 ? -l2g : 0.f);
                const float sc = rstd * (kd == 0 ? 0.0625f : 1.f) * __builtin_amdgcn_exp2f(sgn * (float)((r + 112) & 127));
                bf16_t* base = (bf16_t*)(ws + WS_Q + (size_t)kd * (65 * MiB)); const int cb = nb0 & 255;
#pragma unroll
                for (int g = 0; g < 4; ++g) { u32x2 wv; wv.x = pk2(acc0[4 * g] * sc, acc0[4 * g + 1] * sc); wv.y = pk2(acc0[4 * g + 2] * sc, acc0[4 * g + 3] * sc);
                    const int c = cb + 8 * g;
                    bf16_t* dst = kd == 2 ? base + (size_t)row * 2048 + (nb0 - 2048) + 8 * g + 4 * hh : base + ((size_t)((1024 * 4 + head) * 16 + (c >> 4)) * 64 + ((c >> 3) & 1) * 32 + r) * 8 + 4 * hh;
                    *(u32x2*)dst = wv; }
            } else if (kind == 4) {
                const int head = nb0 >> 9; const f32x4* sp = (const f32x4*)((const float*)(ws + WS_STATS) + ((size_t)row * 4 + head) * 32);
                float s1 = 0.f, s2 = 0.f;
#pragma unroll
                for (int t = 0; t < 8; ++t) { const f32x4 v = sp[t]; s1 += v.x + v.z; s2 += v.y + v.w; }
                const float mu = s1 * (1.f / 512.f); float var = s2 * (1.f / 512.f) - mu * mu; var = var > 0.f ? var : 0.f; const float rs = rsqrtf(var + 1e-6f);
                const bf16_t* osrc = (const bf16_t*)(ws + WS_OMETA) + (size_t)r * 2048 + nb0 + 4 * hh; bf16_t* dst = (bf16_t*)(ws + WS_VO) + (size_t)row * 2048 + nb0 + 4 * hh;
#pragma unroll
                for (int g = 0; g < 4; ++g) { const u32x2 ov = *(const u32x2*)(osrc + 8 * g); u32x2 wv;
                    wv.x = pk2(siluf(acc0[4 * g] * rstd) * (bflo(ov.x) - mu) * rs, siluf(acc0[4 * g + 1] * rstd) * (bfhi(ov.x) - mu) * rs);
                    wv.y = pk2(siluf(acc0[4 * g + 2] * rstd) * (bflo(ov.y) - mu) * rs, siluf(acc0[4 * g + 3] * rstd) * (bfhi(ov.y) - mu) * rs); *(u32x2*)(dst + 8 * g) = wv; }
            } else if (kind == 5) {
                bf16_t* brow = (bf16_t*)(ws + WS_HB) + (size_t)row * DM + 4 * hh; float ss = 0.f;
#pragma unroll
                for (int g = 0; g < 4; ++g) {
                    const u32x2 o0 = *(const u32x2*)(brow + nb0 + 8 * g), o1 = *(const u32x2*)(brow + nb1 + 8 * g);
                    u32x2 w0; w0.x = pk2(bflo(o0.x) + acc0[4 * g], bfhi(o0.x) + acc0[4 * g + 1]); w0.y = pk2(bflo(o0.y) + acc0[4 * g + 2], bfhi(o0.y) + acc0[4 * g + 3]); *(u32x2*)(brow + nb0 + 8 * g) = w0;
                    u32x2 w1; w1.x = pk2(bflo(o1.x) + acc1[4 * g], bfhi(o1.x) + acc1[4 * g + 1]); w1.y = pk2(bflo(o1.y) + acc1[4 * g + 2], bfhi(o1.y) + acc1[4 * g + 3]); *(u32x2*)(brow + nb1 + 8 * g) = w1;
                    ss += (bflo(w0.x) * bflo(w0.x) + bfhi(w0.x) * bfhi(w0.x)) + (bflo(w0.y) * bflo(w0.y) + bfhi(w0.y) * bfhi(w0.y)) + (bflo(w1.x) * bflo(w1.x) + bfhi(w1.x) * bfhi(w1.x)) + (bflo(w1.y) * bflo(w1.y) + bfhi(w1.y) * bfhi(w1.y)); }
                ss += __shfl_xor(ss, 32);
                if (hh == 0) ((float*)(ws + WS_SSQ))[(size_t)row * 16 + task] = ss;
            } else if (kind == 6) {
                bf16_t* dst = (bf16_t*)(ws + WS_ACT) + (size_t)row * FFH + 128 * (task >> 2) + 32 * (task & 3) + 4 * hh;
#pragma unroll
                for (int g = 0; g < 4; ++g) { u32x2 wv; wv.x = pk2(siluf(acc0[4 * g] * rstd) * (acc1[4 * g] * rstd), siluf(acc0[4 * g + 1] * rstd) * (acc1[4 * g + 1] * rstd));
                    wv.y = pk2(siluf(acc0[4 * g + 2] * rstd) * (acc1[4 * g + 2] * rstd), siluf(acc0[4 * g + 3] * rstd) * (acc1[4 * g + 3] * rstd)); *(u32x2*)(dst + 8 * g) = wv; }
            } else {
                bf16_t* dst = (bf16_t*)(ws + WS_P) + (size_t)row * 512 + 32 * task + 4 * hh;
#pragma unroll
                for (int g = 0; g < 4; ++g) { u32x2 wv; wv.x = pk2(acc0[4 * g] * rstd, acc0[4 * g + 1] * rstd); wv.y = pk2(acc0[4 * g + 2] * rstd, acc0[4 * g + 3] * rstd); *(u32x2*)(dst + 8 * g) = wv; }
            }
        }
        __syncthreads();
    }
}

#define XB_TMO      128
#define XB_XCNT(j)  (256  + 64 * (j))
#define XB_XSUB(j)  (1280 + 64 * (j))
#define XB_XGEN(j)  (2304 + 64 * (j))
#define XB_TOP      3328
#define XB_TOPGEN   3392
#define XCD_BAR_WORDS 3456
#define XB_SPIN_CAP (1u << 18)

__device__ __forceinline__ unsigned xb_ld(unsigned* p)              { return __hip_atomic_load(p, __ATOMIC_RELAXED, __HIP_MEMORY_SCOPE_AGENT); }
__device__ __forceinline__ unsigned xb_add(unsigned* p, unsigned v) { return __hip_atomic_fetch_add(p, v, __ATOMIC_RELAXED, __HIP_MEMORY_SCOPE_AGENT); }
__device__ __forceinline__ unsigned xb_xcc_id() { return (unsigned)__builtin_amdgcn_s_getreg((3 << 11) | 20) & 0xFu; }
#define XB_SPIN(cond, bar) do { unsigned _sp = 0; while (cond) { __builtin_amdgcn_s_sleep(1); \
    if ((++_sp & 255u) == 0u) { if (xb_ld(&(bar)[XB_TMO])) break; if (_sp > XB_SPIN_CAP) { atomicAdd(&(bar)[XB_TMO], 1u); break; } } } } while (0)

struct XcdBarrier {
    unsigned* bar; unsigned x;
    volatile LAS unsigned* st;
};

__device__ __forceinline__ XcdBarrier xcd_barrier_post(unsigned* bar, volatile LAS unsigned* st) {
    XcdBarrier b; b.bar = bar; b.x = xb_xcc_id(); b.st = st;
    if (threadIdx.x == 0) (void)xb_add(&bar[XB_XCNT(b.x)], 1u);
    return b;
}
__device__ __forceinline__ void xcd_barrier_complete(unsigned* bar, unsigned x, unsigned& nloc, unsigned& nx) {
    const unsigned G = gridDim.x * gridDim.y * gridDim.z;
    unsigned sum, cnt, mine, sp = 0u;
    for (;;) {
        sum = 0u; cnt = 0u; mine = 0u;
#pragma unroll
        for (unsigned j = 0; j < 16; ++j) { const unsigned c = xb_ld(&bar[XB_XCNT(j)]); sum += c; cnt += (c > 0u) ? 1u : 0u; mine = (j == x) ? c : mine; }
        if (sum == G) break;
        __builtin_amdgcn_s_sleep(1);
        if ((++sp & 255u) == 0u) { if (xb_ld(&bar[XB_TMO])) break; if (sp > XB_SPIN_CAP) { atomicAdd(&bar[XB_TMO], 1u); break; } }
    }
    nloc = mine > 0u ? mine : 1u; nx = cnt > 0u ? cnt : 1u;
}

__device__ __forceinline__ void xcd_barrier(const XcdBarrier& b) {
    asm volatile("s_waitcnt vmcnt(0)" ::: "memory");
    __syncthreads();
    if (threadIdx.x == 0) {
        unsigned* bar = b.bar;
        __builtin_amdgcn_s_waitcnt(0);
        unsigned nloc = b.st[0], nx = b.st[1];
        if (nloc == 0u) { xcd_barrier_complete(bar, b.x, nloc, nx); b.st[0] = nloc; b.st[1] = nx; }
        const unsigned old = xb_add(&bar[XB_XSUB(b.x)], 1u);
        const unsigned gen = old / nloc;
        if (old + 1u == (gen + 1u) * nloc) {
            __builtin_amdgcn_fence(__ATOMIC_RELEASE, "agent");
            asm volatile("s_waitcnt vmcnt(0)" ::: "memory");
            const unsigned og = xb_add(&bar[XB_TOP], 1u);
            const unsigned tg = og / nx;
            if (og + 1u == (tg + 1u) * nx) xb_add(&bar[XB_TOPGEN], 1u);
            else XB_SPIN(xb_ld(&bar[XB_TOPGEN]) == tg, bar);
            __builtin_amdgcn_fence(__ATOMIC_ACQUIRE, "agent");
            xb_add(&bar[XB_XGEN(b.x)], 1u);
            asm volatile("s_waitcnt vmcnt(0)" ::: "memory");
        } else {
            XB_SPIN(xb_ld(&bar[XB_XGEN(b.x)]) == gen, bar);
            __builtin_amdgcn_fence(__ATOMIC_ACQUIRE, "agent");
            asm volatile("s_waitcnt vmcnt(0)" ::: "memory");
        }
    }
    __syncthreads();
}

constexpr int LDS_BYTES = 147456, NPHASE = 26;
__global__ void __launch_bounds__(512, 2) mk_fwd(Args A) {
    extern __shared__ __attribute__((aligned(16))) unsigned char lds_raw[];
    LAS unsigned char* lds = (LAS unsigned char*)lds_raw;
    const int G = gridDim.x, bx = blockIdx.x, vcu = (G % 8 == 0) ? (bx % 8) * (G / 8) + bx / 8 : bx;
    volatile LAS unsigned* MISC = (volatile LAS unsigned*)(lds + 131072 + 320);
    if (threadIdx.x < 32) MISC[threadIdx.x] = 0u;
    __syncthreads();
    const XcdBarrier bar = xcd_barrier_post((unsigned*)(KWS + WS_CTL) , MISC + 8);
    cg::this_grid().sync();
    const int nseq = karg_i(128);
    for (int si = 0; si < nseq; ++si) {
        const int ph = karg_b(132 + si);
#define LTW int tid_x = threadIdx.x; asm volatile("" : "+v"(tid_x)); const int tid = tid_x, lane = tid & 63, w = __builtin_amdgcn_readfirstlane(tid >> 6); (void)tid; (void)lane; (void)w;
        unsigned char* ws = KWS;
        bf16_t* WT = (bf16_t*)(ws + WS_WT); float* ssq = (float*)(ws + WS_SSQ); bf16_t* HB = (bf16_t*)(ws + WS_HB);
        bf16_t* Qb = (bf16_t*)(ws + WS_Q); bf16_t* Kb = (bf16_t*)(ws + WS_K); bf16_t* VO = (bf16_t*)(ws + WS_VO); bf16_t* ACT = (bf16_t*)(ws + WS_ACT);
        int kind, l;
        const bf16_t* gA = nullptr; const bf16_t* gB = nullptr; int gM = MREAL, gN = 1024, gK = 1024; bool meta = false;
        if (ph == 0) { kind = 0; l = 0; }
        else if (ph <= 14) { l = (ph - 1) / 7; const int k = (ph - 1) % 7; meta = true;
            if (k == 0) { kind = 1; gA = HB; gB = WT + WO_WIN + (size_t)l * 6291456; gN = 4096; }
            else if (k == 1) kind = 2; else if (k == 2) kind = 3;
            else if (k == 3) { kind = 4; gA = HB; gB = WT + WO_WIN + (size_t)l * 6291456 + (size_t)4096 * 1024; gN = 2048; }
            else if (k == 4) { kind = 5; gA = VO; gB = WT + WO_WOUT + (size_t)l * 2097152; gK = 2048; }
            else if (k == 5) { kind = 6; gA = HB; gB = WT + WO_FFI + (size_t)l * 5767168; gN = 5632; }
            else { kind = 5; gA = ACT; gB = WT + WO_FFO + (size_t)l * 2883584; gK = FFH; } }
        else if (ph <= 24) { l = 2 + (ph - 15) / 5; const int k = (ph - 15) % 5; gM = MREAL;
            if (k == 0) { kind = 7; gA = HB; if (l == 2) { gB = WT + WO_QKV2; gN = 1536; meta = true; } else { gB = WT + WO_Q3; gN = 1024; } }
            else if (k == 1) kind = 8;
            else if (k == 2) { kind = 5; gA = VO; gB = WT + WO_WO + (size_t)(l - 2) * 1048576; }
            else if (k == 3) { kind = 6; gA = HB; gB = WT + WO_FFI + (size_t)l * 5767168; gN = 5632; }
            else { kind = 5; gA = ACT; gB = WT + WO_FFO + (size_t)l * 2883584; gK = FFH; } }
        else if (ph == 25) { kind = 9; l = 0; }
        else { kind = 10; l = 0; }
        pg8::Gemm g{gA, gB, gM, gN, gK}; pg8::StaticOrder S; S.init(gM, gN, G, bx);
        if (meta && (kind == 1 || (kind >= 4 && kind <= 7))) { LTW skinny_phase(lds, kind, gA, gB, gK, ws, vcu, G, w, lane); }
        if (kind == 0) { LTW prologue(lds, vcu * 8 + w, G * 8, w, lane); }
        else if (kind == 1) { pg8::EpiRetIn E{ws, ssq}; pg8::gemm_phase<pg8::EpiRetIn, pg8::StaticOrder, true, true>(lds, g, S, E); }
        else if (kind == 2) { LTW p_phase(lds, Qb, Kb, (bf16_t*)(ws + WS_P), (bf16_t*)KOUT, vcu, G, w, lane); }
        else if (kind == 3) scan_phase(lds, Qb, (const bf16_t*)KOUT, VO, (bf16_t*)(ws + WS_OMETA), (const bf16_t*)(ws + WS_P), (float*)(ws + WS_STATS), vcu, G);
        else if (kind == 4) { pg8::EpiG E{VO, (const bf16_t*)(ws + WS_OMETA), ssq, (const float*)(ws + WS_STATS)}; pg8::gemm_phase<pg8::EpiG, pg8::StaticOrder, true, true>(lds, g, S, E); }
        else if (kind == 5) { pg8::EpiRes E{HB, ssq}; pg8::gemm_phase<pg8::EpiRes, pg8::StaticOrder, true, true>(lds, g, S, E); }
        else if (kind == 6) { pg8::EpiFfnIn E{ACT, ssq}; pg8::gemm_phase<pg8::EpiFfnIn, pg8::StaticOrder, true, true>(lds, g, S, E); }
        else if (kind == 7) { pg8::EpiQKV E{Qb, (bf16_t*)(ws + WS_P), ssq};     pg8::gemm_phase<pg8::EpiQKV, pg8::StaticOrder, true, true>(lds, g, S, E); }
        else if (kind == 8) { LTW attn_phase(lds, Qb, (const bf16_t*)(ws + WS_P), VO, KIN(10) + (l - 2) * 16, vcu, G, w, lane, tid); }
        else if (kind == 9) { LTW final_norm(vcu * 8 + w, G * 8, lane); }
        if (si + 1 < nseq) xcd_barrier(bar);
    }
}

extern "C" void kernel_launch(void* const* d_in, const int* in_sizes, int n_in, void* d_out, int out_size, void* d_ws, size_t ws_size, hipStream_t stream) {
    static int grid = 0;
    if (grid == 0) {
        if (n_in != 14 || out_size != MREAL * DM || ws_size < WS_END) { fprintf(stderr, "kernel_launch: unexpected shapes (n_in %d out %d ws %zu)\n", n_in, out_size, ws_size); grid = -1; return; }
        int dev = 0, cus = 0, per_cu = 0;
        hipGetDevice(&dev); hipDeviceGetAttribute(&cus, hipDeviceAttributeMultiprocessorCount, dev);
        if (hipFuncSetAttribute((const void*)mk_fwd, hipFuncAttributeMaxDynamicSharedMemorySize, LDS_BYTES) != hipSuccess) { fprintf(stderr, "kernel_launch: hipFuncSetAttribute failed\n"); grid = -1; return; }
        if (hipOccupancyMaxActiveBlocksPerMultiprocessor(&per_cu, (const void*)mk_fwd, 512, LDS_BYTES) != hipSuccess || per_cu < 1) { fprintf(stderr, "kernel_launch: occupancy query says %d\n", per_cu); per_cu = 1; }
        (void)hipGetLastError();
        grid = cus;
    }
    if (grid < 0) return;
    if (hipMemsetAsync((char*)d_ws + WS_CTL, 0, 16384, stream) != hipSuccess) { fprintf(stderr, "kernel_launch: memset failed\n"); return; }
    Args a{};
    for (int i = 0; i < 14; ++i) a.in[i] = (const float*)d_in[i];
    a.out = (float*)d_out; a.ws = (unsigned char*)d_ws;
#ifndef PROBE_SEQ
#define PROBE_SEQ 0
#endif
    int n = 0;
    for (int ph = 0; ph < NPHASE; ++ph) {
        a.seq[n++] = (unsigned char)ph;
#if PROBE_SEQ == 1
        if (ph == 0) for (int k = 0; k < 50; ++k) a.seq[n++] = 30;
#elif PROBE_SEQ == 2
        if (ph == 1 || ph == 8) a.seq[n++] = (unsigned char)ph;
#elif PROBE_SEQ == 3
        if (ph == 3 || ph == 10) { a.seq[n++] = (unsigned char)(ph - 2); a.seq[n++] = (unsigned char)(ph - 1); a.seq[n++] = (unsigned char)ph; }
#elif PROBE_SEQ == 4
        if (ph == 16 || ph == 21 || ph == 0) a.seq[n++] = (unsigned char)ph;
#elif PROBE_SEQ == 6
        if (ph == 2 || ph == 9) a.seq[n++] = (unsigned char)ph;
#elif PROBE_SEQ == 5
        if (ph == 6 || ph == 13 || ph == 18 || ph == 23) a.seq[n++] = (unsigned char)ph;
#endif
    }
    a.nseq = n;
    void* args[] = {&a};
    hipError_t e = hipLaunchCooperativeKernel((const void*)mk_fwd, dim3(grid), dim3(512), args, LDS_BYTES, stream);
    if (e != hipSuccess) fprintf(stderr, "cooperative launch failed: %s (grid %d)\n", hipGetErrorString(e), grid);
}
```

```cpp
#include <hip/hip_runtime.h>
#include <hip/hip_cooperative_groups.h>
#include <cstdio>
#include <cstdint>
namespace cg = cooperative_groups;
#ifndef MK_MULTI
#define MK_MULTI 0
#endif
#ifndef PROBE_SEQ
#define PROBE_SEQ 0
#endif
namespace pg8 {
#define PG8_LAS __attribute__((address_space(3)))
typedef unsigned short bf16_t;
typedef short bf16x8 __attribute__((ext_vector_type(8)));
typedef float f32x4 __attribute__((ext_vector_type(4)));
typedef unsigned u32x4 __attribute__((ext_vector_type(4)));
constexpr int BM = 256, BK = 64, HALF = 128, HTB = HALF * BK * 2  , STAGE_BYTES = 8 * HTB, NXCD = 8, WGM = 8;

__host__ __device__ __forceinline__ int lds_byte(int r, int c) { const int st = (r >> 4) * 2 + (c >> 5), rr = r & 15, cc = c & 31, ob = rr * 64 + cc * 2; return st * 1024 + (ob ^ (((ob >> 9) & 1) << 5)); }
__host__ __device__ __forceinline__ void stage_rc(int b, int& R, int& C) { const int st = b / 1024, sb = b % 1024, swz = sb ^ (((sb >> 9) & 1) << 5); R = (st >> 1) * 16 + swz / 64; C = (st & 1) * 32 + (swz % 64) / 2; }
__host__ __device__ __forceinline__ int perm32(int rho) { const int n = rho >> 4, i = rho & 15; return 8 * (i >> 2) + 4 * n + (i & 3); }

struct Unit { int pm, pn; };
struct Gemm { const bf16_t* A; const bf16_t* Bt; int M, N, K; };

struct StaticOrder {
    int nM, nN, nwg, G, c;
    __host__ __device__ void init(int M, int N, int G_, int c_) { nM = M / BM; nN = N / BM; nwg = nM * nN; G = G_; c = c_; }
    __host__ __device__ bool next(int i, Unit& u) const {
        const long L = (long)i * G + c; if (L >= nwg) return false;
        int wgid = (int)L; { const int q = nwg / NXCD, r = nwg % NXCD, xcd = wgid % NXCD, off = wgid / NXCD; wgid = (xcd < r ? xcd * (q + 1) : r * (q + 1) + (xcd - r) * q) + off; }
        const int nig = WGM * nN, gid = wgid / nig, fm = gid * WGM, gsz = (nM - fm) < WGM ? (nM - fm) : WGM;
        u.pm = fm + ((wgid % nig) % gsz); u.pn = (wgid % nig) / gsz; return true;
    }
    __device__ __forceinline__ void a_ready(const Unit&) const {}
    __device__ __forceinline__ void done(const Unit&) const {}
};


template <class Epi, class Sched, bool ALIGN_EPI = false, bool SP2 = false>
__device__ __forceinline__ void gemm_phase(PG8_LAS unsigned char* lds, const Gemm g, const Sched& S, const Epi& E) {
    int tid_l = threadIdx.x; asm volatile("" : "+v"(tid_l));
    const int tid = tid_l, wid = __builtin_amdgcn_readfirstlane(tid >> 6), lane = tid & 63, wr = wid >> 2, wc = wid & 3, fr = lane & 15, fq = lane >> 4;
    const int K = g.K, nt = K / BK;
    unsigned voffA[2], voffB[2];
#pragma unroll
    for (int i = 0; i < 2; ++i) { int R, C; stage_rc(tid * 16 + i * 8192, R, C); const int Rb = Epi::PERM ? ((R & ~31) + perm32(R & 31)) : R;
        voffA[i] = (unsigned)(R * K + C) * 2u; voffB[i] = (unsigned)(Rb * K + C) * 2u; }
    const size_t kstep = (size_t)(BK * 2);
    const size_t hstep = (size_t)HALF * K * 2;
    const size_t tstep = 2 * hstep;
    const unsigned ldsw = (unsigned)wid * 1024u;
    const int aoff = lds_byte(wr * 64 + fr, fq * 8), boff = lds_byte(wc * 32 + fr, fq * 8);
#define PG8_SA(b, h) (((b) * 2 + (h)) * HTB)
#define PG8_SB(b, h) ((4 + (b) * 2 + (h)) * HTB)
#define PG8_STAGE(bufoff, gbase, voff) do { _Pragma("unroll") for (int _i = 0; _i < 2; ++_i) \
        __builtin_amdgcn_global_load_lds((const unsigned*)((const char*)(gbase) + (voff)[_i]), (PG8_LAS unsigned*)(lds + (bufoff) + ldsw + _i * 8192), 16, 0, 0); } while (0)
#define PG8_LDA(dst, b, h) do { _Pragma("unroll") for (int m = 0; m < 4; ++m) _Pragma("unroll") for (int k = 0; k < 2; ++k) dst[m][k] = *(const PG8_LAS bf16x8*)(lds + PG8_SA(b, h) + aoff + m * 2048 + k * 1024); } while (0)
#define PG8_LDB(dst, b, h) do { _Pragma("unroll") for (int n = 0; n < 2; ++n) _Pragma("unroll") for (int k = 0; k < 2; ++k) dst[n][k] = *(const PG8_LAS bf16x8*)(lds + PG8_SB(b, h) + boff + n * 2048 + k * 1024); } while (0)
#define PG8_MMA(ai, bj, At, Bt) do { __builtin_amdgcn_s_setprio(1); _Pragma("unroll") for (int m = 0; m < 4; ++m) _Pragma("unroll") for (int n = 0; n < 2; ++n) _Pragma("unroll") for (int k = 0; k < 2; ++k) \
        acc[ai][bj][m][n] = __builtin_amdgcn_mfma_f32_16x16x32_bf16(Bt[n][k], At[m][k], acc[ai][bj][m][n], 0, 0, 0); __builtin_amdgcn_s_setprio(0); } while (0)
#define PG8_WAIT_V(n) asm volatile("s_waitcnt vmcnt(" #n ")" ::: "memory")
#define PG8_WAIT_L(n) asm volatile("s_waitcnt lgkmcnt(" #n ")" ::: "memory")
#define PG8_BAR __builtin_amdgcn_s_barrier()
#define PG8_SCHED __builtin_amdgcn_sched_barrier(0)
    Unit cur, nxt; int ui = 0;
    if (!S.next(0, cur)) return;
    f32x4 acc[2][2][4][2];
#pragma unroll
    for (int a = 0; a < 2; ++a)
#pragma unroll
        for (int b = 0; b < 2; ++b)
#pragma unroll
            for (int m = 0; m < 4; ++m)
#pragma unroll
                for (int n = 0; n < 2; ++n) acc[a][b][m][n] = (f32x4){0.f, 0.f, 0.f, 0.f};
    bf16x8 At[4][2], B0[2][2], B1[2][2];
    const char* cA = (const char*)g.A + (size_t)cur.pm * tstep; const char* cB = (const char*)g.Bt + (size_t)cur.pn * tstep;
    S.a_ready(cur);
    if constexpr (SP2) {
        PG8_STAGE(PG8_SB(0, 0), cB, voffB); PG8_STAGE(PG8_SB(0, 1), cB + hstep, voffB); PG8_STAGE(PG8_SA(0, 0), cA, voffA); PG8_STAGE(PG8_SA(0, 1), cA + hstep, voffA);
        if (wr == 1) PG8_BAR;
        PG8_WAIT_V(2); PG8_BAR;
        PG8_STAGE(PG8_SB(1, 0), cB + kstep, voffB); PG8_STAGE(PG8_SA(1, 0), cA + kstep, voffA); PG8_STAGE(PG8_SB(1, 1), cB + hstep + kstep, voffB);
        PG8_WAIT_V(6); PG8_BAR;
    } else {
        PG8_STAGE(PG8_SB(0, 0), cB, voffB); PG8_STAGE(PG8_SA(0, 0), cA, voffA); PG8_STAGE(PG8_SB(0, 1), cB + hstep, voffB); PG8_STAGE(PG8_SA(0, 1), cA + hstep, voffA);
        if (wr == 1) PG8_BAR;
        PG8_WAIT_V(4); PG8_BAR;
        PG8_STAGE(PG8_SB(1, 0), cB + kstep, voffB); PG8_STAGE(PG8_SA(1, 0), cA + kstep, voffA); PG8_STAGE(PG8_SB(1, 1), cB + hstep + kstep, voffB);
        PG8_WAIT_V(6); PG8_BAR;
    }
    for (;;) {
        const bool has_next = S.next(ui + 1, nxt);
        const char* nA = has_next ? (const char*)g.A + (size_t)nxt.pm * tstep : cA; const char* nB = has_next ? (const char*)g.Bt + (size_t)nxt.pn * tstep : cB;
        for (int t = 0; t < nt; t += 2) {
            const bool last = (t == nt - 2);
            const char* a1 = cA + (size_t)(t + 1) * kstep;
            const char* a2 = last ? nA : cA + (size_t)(t + 2) * kstep; const char* b2 = last ? nB : cB + (size_t)(t + 2) * kstep;
            const char* a3 = a2 + kstep; const char* b3 = b2 + kstep;
            if (last && has_next) S.a_ready(nxt);
            if constexpr (SP2) {
            PG8_LDB(B0, 0, 0); PG8_LDB(B1, 0, 1); PG8_SCHED; PG8_LDA(At, 0, 0); PG8_STAGE(PG8_SA(1, 1), a1 + hstep, voffA);
            PG8_WAIT_V(8); PG8_WAIT_L(0); PG8_BAR; PG8_MMA(0, 0, At, B0); PG8_MMA(0, 1, At, B1); PG8_BAR; PG8_SCHED;
            PG8_LDA(At, 0, 1); PG8_STAGE(PG8_SB(0, 0), b2, voffB); PG8_STAGE(PG8_SB(0, 1), b2 + hstep, voffB); PG8_STAGE(PG8_SA(0, 0), a2, voffA);
            PG8_WAIT_V(8); PG8_WAIT_L(0); PG8_BAR; PG8_MMA(1, 0, At, B0); PG8_MMA(1, 1, At, B1); PG8_BAR; PG8_SCHED;
            PG8_LDB(B0, 1, 0); PG8_LDB(B1, 1, 1); PG8_SCHED; PG8_LDA(At, 1, 0); PG8_STAGE(PG8_SA(0, 1), a2 + hstep, voffA);
            PG8_WAIT_V(8); PG8_WAIT_L(0); PG8_BAR; PG8_MMA(0, 0, At, B0); PG8_MMA(0, 1, At, B1); PG8_BAR; PG8_SCHED;
            PG8_LDA(At, 1, 1); PG8_STAGE(PG8_SB(1, 0), b3, voffB); PG8_STAGE(PG8_SB(1, 1), b3 + hstep, voffB); PG8_STAGE(PG8_SA(1, 0), a3, voffA);
            PG8_WAIT_V(8); PG8_WAIT_L(0); PG8_BAR; PG8_MMA(1, 0, At, B0); PG8_MMA(1, 1, At, B1); PG8_BAR; PG8_SCHED;
            } else {
            PG8_LDB(B0, 0, 0); PG8_SCHED; PG8_LDA(At, 0, 0); PG8_STAGE(PG8_SA(1, 1), a1 + hstep, voffA);
            PG8_WAIT_L(8); PG8_BAR; PG8_WAIT_L(0); PG8_MMA(0, 0, At, B0); PG8_BAR; PG8_SCHED;
            PG8_LDB(B1, 0, 1); PG8_STAGE(PG8_SB(0, 0), b2, voffB);
            PG8_BAR; PG8_WAIT_L(0); PG8_MMA(0, 1, At, B1); PG8_BAR;
            PG8_LDA(At, 0, 1); PG8_STAGE(PG8_SA(0, 0), a2, voffA);
            PG8_BAR; PG8_WAIT_L(0); PG8_MMA(1, 0, At, B0); PG8_BAR; PG8_SCHED;
            PG8_STAGE(PG8_SB(0, 1), b2 + hstep, voffB);
            PG8_WAIT_V(6); PG8_BAR; PG8_MMA(1, 1, At, B1); PG8_BAR;
            PG8_LDB(B0, 1, 0); PG8_SCHED; PG8_LDA(At, 1, 0); PG8_STAGE(PG8_SA(0, 1), a2 + hstep, voffA);
            PG8_WAIT_L(8); PG8_BAR; PG8_WAIT_L(0); PG8_MMA(0, 0, At, B0); PG8_BAR; PG8_SCHED;
            PG8_LDB(B1, 1, 1); PG8_STAGE(PG8_SB(1, 0), b3, voffB);
            PG8_BAR; PG8_WAIT_L(0); PG8_MMA(0, 1, At, B1); PG8_BAR;
            PG8_LDA(At, 1, 1); PG8_STAGE(PG8_SA(1, 0), a3, voffA);
            PG8_BAR; PG8_WAIT_L(0); PG8_MMA(1, 0, At, B0); PG8_BAR; PG8_SCHED;
            PG8_STAGE(PG8_SB(1, 1), b3 + hstep, voffB);
            PG8_WAIT_V(6); PG8_BAR; PG8_MMA(1, 1, At, B1); PG8_BAR;
            }
        }
        if constexpr (ALIGN_EPI) { if (wr == 0) PG8_BAR; }
        if constexpr (!Epi::AFTER_DRAIN) { E(acc, cur, wr, wc, fr, fq); S.done(cur); }
        if (!has_next) break;
#pragma unroll
        for (int a = 0; a < 2; ++a)
#pragma unroll
            for (int b = 0; b < 2; ++b)
#pragma unroll
                for (int m = 0; m < 4; ++m)
#pragma unroll
                    for (int n = 0; n < 2; ++n) acc[a][b][m][n] = (f32x4){0.f, 0.f, 0.f, 0.f};
        cur = nxt; cA = nA; cB = nB; ++ui;
        if constexpr (ALIGN_EPI) { if (wr == 1) PG8_BAR; }
    }
    PG8_WAIT_V(0);
    if constexpr (!ALIGN_EPI) { if (wr == 0) PG8_BAR; }
    PG8_BAR;
    if constexpr (Epi::AFTER_DRAIN) { E.fused(acc, cur, wr, wc, fr, fq, lds, wid, lane); S.done(cur); }
#undef PG8_SA
#undef PG8_SB
#undef PG8_STAGE
#undef PG8_LDA
#undef PG8_LDB
#undef PG8_MMA
#undef PG8_WAIT_V
#undef PG8_WAIT_L
#undef PG8_BAR
#undef PG8_SCHED
}
}

constexpr int DM = 1024, MREAL = 32768, MP = 33024, FFH = 2816;
constexpr size_t MiB = 1u << 20;
constexpr size_t WS_CTL = 0;
constexpr size_t WS_SSQ = 1 * MiB;
constexpr size_t WS_HMETA = 4 * MiB;
constexpr size_t WS_OMETA = 5 * MiB;
constexpr size_t WS_HB = 8 * MiB;
constexpr size_t WS_WT = 73 * MiB;
constexpr size_t WS_T = 180 * MiB;
constexpr size_t WS_Q = WS_T;
constexpr size_t WS_K = WS_T + 65 * MiB;
constexpr size_t WS_VO = WS_T + 130 * MiB;
constexpr size_t WS_P = WS_T + 259 * MiB;
constexpr size_t WS_STATS = WS_T + 292 * MiB;
constexpr size_t WS_ACT = WS_T;
constexpr size_t WS_END = 512 * MiB;
static_assert(WS_STATS + (size_t)MP * 4 * 32 * 4 <= WS_END, "ws map");
static_assert(WS_P + (size_t)32 * 33 * 16384 * 2 <= WS_STATS, "ws map");
static_assert(WS_HB + (size_t)MP * 1024 * 2 <= WS_WT, "ws map");
constexpr size_t WO_WIN = 0, WO_WOUT = 12582912, WO_FFI = 16777216, WO_FFO = 39845888, WO_QKV2 = 51380224, WO_Q3 = 52953088, WO_WO = 54001664, WO_END = 56098816;
static_assert(WS_WT + WO_END * 2 <= WS_T, "ws map");

#define LAS __attribute__((address_space(3)))
typedef unsigned short bf16_t;
typedef short bf16x8 __attribute__((ext_vector_type(8)));
typedef short v4i16_t __attribute__((ext_vector_type(4)));
typedef float f32x4 __attribute__((ext_vector_type(4)));
typedef float f32x16 __attribute__((ext_vector_type(16)));
typedef unsigned u32x4 __attribute__((ext_vector_type(4)));
typedef unsigned u32x2 __attribute__((ext_vector_type(2)));
typedef float f32x2_t __attribute__((ext_vector_type(2)));
typedef __bf16 bf16x2_t __attribute__((ext_vector_type(2)));
#define MFMA32(a, b, c) __builtin_amdgcn_mfma_f32_32x32x16_bf16((a), (b), (c), 0, 0, 0)
#define DI __device__ __forceinline__
DI unsigned pk2(float lo, float hi) { f32x2_t v = {lo, hi}; bf16x2_t b = __builtin_convertvector(v, bf16x2_t); return __builtin_bit_cast(unsigned, b); }
DI float bflo(unsigned u) { return __builtin_bit_cast(float, u << 16); }
DI float bfhi(unsigned u) { return __builtin_bit_cast(float, u & 0xffff0000u); }
DI int crow(int reg, int h) { return (reg & 3) + 8 * (reg >> 2) + 4 * h; }
DI float siluf(float g) { return g * __builtin_amdgcn_rcpf(1.f + __builtin_amdgcn_exp2f(g * -1.4426950408889634f)); }
DI float row_rstd(const float* ssq, int r) {
    const f32x4* p = (const f32x4*)(ssq + (size_t)r * 16);
    const f32x4 a = p[0], b = p[1], c = p[2], d = p[3];
    const float s = ((a.x + a.y) + (a.z + a.w)) + ((b.x + b.y) + (b.z + b.w)) + ((c.x + c.y) + (c.z + c.w)) + ((d.x + d.y) + (d.z + d.w));
    return rsqrtf(s * (1.f / 1024.f) + 1e-6f);
}
DI float xsum_row4(float v) {
    v += __shfl_xor(v, 16); v += __shfl_xor(v, 32); return v;
}
DI float rstd_of(const f32x4 a) { return rsqrtf(xsum_row4((a.x + a.y) + (a.z + a.w)) * (1.f / 1024.f) + 1e-6f); }
DI float row_rstd4(const float* ssq, int r, int fq) {
    const f32x4 a = *(const f32x4*)(ssq + (size_t)r * 16 + 4 * fq);
    float s = (a.x + a.y) + (a.z + a.w); s += __shfl_xor(s, 16); s += __shfl_xor(s, 32);
    return rsqrtf(s * (1.f / 1024.f) + 1e-6f);
}
DI float head_l2g(int h) { return __builtin_amdgcn_logf(1.f - __builtin_amdgcn_exp2f(-5.f - (float)h)); }
DI const void* karg(int i) { const __attribute__((address_space(4))) char* k = (const __attribute__((address_space(4))) char*)__builtin_amdgcn_kernarg_segment_ptr(); return *(const void* const volatile __attribute__((address_space(4)))*)(k + 8 * i); }
DI int karg_b(int off) { const __attribute__((address_space(4))) char* k = (const __attribute__((address_space(4))) char*)__builtin_amdgcn_kernarg_segment_ptr(); return *(const volatile __attribute__((address_space(4))) unsigned char*)(k + off); }
DI int karg_i(int off) { const __attribute__((address_space(4))) char* k = (const __attribute__((address_space(4))) char*)__builtin_amdgcn_kernarg_segment_ptr(); return *(const volatile __attribute__((address_space(4))) int*)(k + off); }
#define KIN(i) ((const float*)karg(i))
#define KOUT ((float*)karg(14))
#define KWS ((unsigned char*)karg(15))

namespace pg8 {
struct EpiRetIn {
    static constexpr bool PERM = true, AFTER_DRAIN = false;
    unsigned char* ws; const float* ssq;
    __device__ __forceinline__ void operator()(const f32x4 (&acc)[2][2][4][2], const Unit& u, int wr, int wc, int fr, int fq) const {
        const int pn = u.pn, kind = pn < 4 ? 0 : (pn < 8 ? 1 : 2), head = pn & 3;
        const float l2g = __builtin_amdgcn_logf(1.f - __builtin_amdgcn_exp2f(-5.f - (float)head));
        bf16_t* base = (bf16_t*)(ws + WS_Q + (size_t)kind * (65 * MiB));
        const int ldc = 1024 << (kind >> 1), colt = (kind == 2 ? pn - 8 : head) * 256;
        const int col0 = colt + wc * 32 + 8 * fq;
        const float sgn = kind == 0 ? l2g : (kind == 1 ? -l2g : 0.f), mul = kind == 0 ? 0.0625f : 1.f;
        const int r0 = u.pm * BM + wr * 64 + fr;
        f32x4 pq[2][4];
#pragma unroll
        for (int ai = 0; ai < 2; ++ai)
#pragma unroll
            for (int m = 0; m < 4; ++m) pq[ai][m] = *(const f32x4*)(ssq + (size_t)(r0 + ai * HALF + m * 16) * 16 + 4 * fq);
        __builtin_amdgcn_sched_barrier(0);
        float rsv[2][4];
#pragma unroll
        for (int ai = 0; ai < 2; ++ai)
#pragma unroll
            for (int m = 0; m < 4; ++m) rsv[ai][m] = rstd_of(pq[ai][m]);
        __builtin_amdgcn_sched_barrier(0);
#pragma unroll
        for (int ai = 0; ai < 2; ++ai)
#pragma unroll
            for (int m = 0; m < 4; ++m) {
                const int r = r0 + ai * HALF + m * 16;
                const int pos = (r < MREAL) ? (r & 127) : ((r + 112) & 127);
                const float sc = rsv[ai][m] * mul * __builtin_amdgcn_exp2f(sgn * (float)pos);
                const int cq = wc * 32 + 8 * fq;
                bf16_t* rowp = kind == 2 ? base + (size_t)r * ldc + col0 : base + ((size_t)(((r >> 5) * 4 + head) * 16 + (cq >> 4)) * 64 + ((cq >> 3) & 1) * 32 + (r & 31)) * 8;
                const int bjstep = kind == 2 ? HALF : 8 * 512;
#pragma unroll
                for (int bj = 0; bj < 2; ++bj) { const f32x4 v0 = acc[ai][bj][m][0] * sc, v1 = acc[ai][bj][m][1] * sc;
                    u32x4 w; w.x = pk2(v0[0], v0[1]); w.y = pk2(v0[2], v0[3]); w.z = pk2(v1[0], v1[1]); w.w = pk2(v1[2], v1[3]);
                    *(u32x4*)(rowp + bj * bjstep) = w; }
            }
    }
};
struct EpiG {
    static constexpr bool PERM = true, AFTER_DRAIN = false;
    bf16_t* VO; const bf16_t* Ometa; const float* ssq; const float* stats;
    __device__ __forceinline__ void operator()(const f32x4 (&acc)[2][2][4][2], const Unit& u, int wr, int wc, int fr, int fq) const {
        const int head = u.pn >> 1, col0 = u.pn * 256 + wc * 32 + 8 * fq;
        const int r0 = u.pm * BM + wr * 64 + fr;
#pragma unroll
        for (int ai = 0; ai < 2; ++ai) {
            f32x4 pq[4], sa[4], sb[4]; u32x4 ov[4][2];
#pragma unroll
            for (int m = 0; m < 4; ++m) { const int r = r0 + ai * HALF + m * 16;
                pq[m] = *(const f32x4*)(ssq + (size_t)r * 16 + 4 * fq);
                const f32x4* sp = (const f32x4*)(stats + ((size_t)r * 4 + head) * 32) + 2 * fq; sa[m] = sp[0]; sb[m] = sp[1];
                const bf16_t* orow = (r < MREAL ? VO + (size_t)r * 2048 : Ometa + (size_t)(r - MREAL) * 2048) + col0;
                ov[m][0] = *(const u32x4*)orow; ov[m][1] = *(const u32x4*)(orow + HALF); }
            __builtin_amdgcn_sched_barrier(0);
            float rsv[4], s1v[4], s2v[4];
#pragma unroll
            for (int m = 0; m < 4; ++m) { rsv[m] = rstd_of(pq[m]); s1v[m] = xsum_row4((sa[m].x + sa[m].z) + (sb[m].x + sb[m].z)); s2v[m] = xsum_row4((sa[m].y + sa[m].w) + (sb[m].y + sb[m].w)); }
            __builtin_amdgcn_sched_barrier(0);
#pragma unroll
            for (int m = 0; m < 4; ++m) { const int r = r0 + ai * HALF + m * 16;
                const float rstd = rsv[m];
                const float s1 = s1v[m], s2 = s2v[m];
                const float mu = s1 * (1.f / 512.f); float var = s2 * (1.f / 512.f) - mu * mu; var = var > 0.f ? var : 0.f;
                const float rs = rsqrtf(var + 1e-6f);
                bf16_t* wrow = VO + (size_t)r * 2048 + col0;
#pragma unroll
                for (int bj = 0; bj < 2; ++bj) { const u32x4 o4 = ov[m][bj];
                    const f32x4 g0 = acc[ai][bj][m][0] * rstd, g1 = acc[ai][bj][m][1] * rstd;
                    u32x4 w;
                    w.x = pk2(siluf(g0[0]) * (bflo(o4.x) - mu) * rs, siluf(g0[1]) * (bfhi(o4.x) - mu) * rs);
                    w.y = pk2(siluf(g0[2]) * (bflo(o4.y) - mu) * rs, siluf(g0[3]) * (bfhi(o4.y) - mu) * rs);
                    w.z = pk2(siluf(g1[0]) * (bflo(o4.z) - mu) * rs, siluf(g1[1]) * (bfhi(o4.z) - mu) * rs);
                    w.w = pk2(siluf(g1[2]) * (bflo(o4.w) - mu) * rs, siluf(g1[3]) * (bfhi(o4.w) - mu) * rs);
                    *(u32x4*)(wrow + bj * HALF) = w; }
            }
        }
    }
};
struct EpiRes {
    static constexpr bool PERM = true, AFTER_DRAIN = false;
    bf16_t* HB; float* ssq;
    __device__ __forceinline__ void operator()(const f32x4 (&acc)[2][2][4][2], const Unit& u, int wr, int wc, int fr, int fq) const {
        const int col0 = u.pn * BM + wc * 32 + 8 * fq;
        const int r0 = u.pm * BM + wr * 64 + fr;
        float ssv[2][4];
        u32x4 ov[2][4][2];
#pragma unroll
        for (int ai = 0; ai < 2; ++ai)
#pragma unroll
            for (int m = 0; m < 4; ++m) { const bf16_t* brow = HB + (size_t)(r0 + ai * HALF + m * 16) * DM + col0; ov[ai][m][0] = *(const u32x4*)brow; ov[ai][m][1] = *(const u32x4*)(brow + HALF); }
        __builtin_amdgcn_sched_barrier(0);
#pragma unroll
        for (int ai = 0; ai < 2; ++ai)
#pragma unroll
            for (int m = 0; m < 4; ++m) {
                const int r = r0 + ai * HALF + m * 16;
                bf16_t* brow = HB + (size_t)r * DM + col0;
                float ss = 0.f;
#pragma unroll
                for (int bj = 0; bj < 2; ++bj) { const u32x4 o4 = ov[ai][m][bj]; const f32x4 a0 = acc[ai][bj][m][0], a1 = acc[ai][bj][m][1];
                    u32x4 w; w.x = pk2(bflo(o4.x) + a0[0], bfhi(o4.x) + a0[1]); w.y = pk2(bflo(o4.y) + a0[2], bfhi(o4.y) + a0[3]);
                    w.z = pk2(bflo(o4.z) + a1[0], bfhi(o4.z) + a1[1]); w.w = pk2(bflo(o4.w) + a1[2], bfhi(o4.w) + a1[3]);
                    *(u32x4*)(brow + bj * HALF) = w;
                    ss += (bflo(w.x) * bflo(w.x) + bfhi(w.x) * bfhi(w.x)) + (bflo(w.y) * bflo(w.y) + bfhi(w.y) * bfhi(w.y)) + (bflo(w.z) * bflo(w.z) + bfhi(w.z) * bfhi(w.z)) + (bflo(w.w) * bflo(w.w) + bfhi(w.w) * bfhi(w.w)); }
                ssv[ai][m] = ss;
            }
#pragma unroll
        for (int ai = 0; ai < 2; ++ai)
#pragma unroll
            for (int m = 0; m < 4; ++m) ssv[ai][m] = xsum_row4(ssv[ai][m]);
        if (fq == 0) {
#pragma unroll
            for (int ai = 0; ai < 2; ++ai)
#pragma unroll
                for (int m = 0; m < 4; ++m) ssq[(size_t)(r0 + ai * HALF + m * 16) * 16 + u.pn * 4 + wc] = ssv[ai][m];
        }
    }
};
struct EpiFfnIn {
    static constexpr bool PERM = true, AFTER_DRAIN = false;
    bf16_t* ACT; const float* ssq;
    __device__ __forceinline__ void operator()(const f32x4 (&acc)[2][2][4][2], const Unit& u, int wr, int wc, int fr, int fq) const {
        const int col0 = u.pn * 128 + wc * 32 + 8 * fq;
        const int r0 = u.pm * BM + wr * 64 + fr;
        f32x4 pq[2][4];
#pragma unroll
        for (int ai = 0; ai < 2; ++ai)
#pragma unroll
            for (int m = 0; m < 4; ++m) pq[ai][m] = *(const f32x4*)(ssq + (size_t)(r0 + ai * HALF + m * 16) * 16 + 4 * fq);
        __builtin_amdgcn_sched_barrier(0);
        float rsv[2][4];
#pragma unroll
        for (int ai = 0; ai < 2; ++ai)
#pragma unroll
            for (int m = 0; m < 4; ++m) rsv[ai][m] = rstd_of(pq[ai][m]);
        __builtin_amdgcn_sched_barrier(0);
#pragma unroll
        for (int ai = 0; ai < 2; ++ai)
#pragma unroll
            for (int m = 0; m < 4; ++m) {
                const int r = r0 + ai * HALF + m * 16;
                const float rstd = rsv[ai][m];
                const f32x4 g0 = acc[ai][0][m][0] * rstd, g1 = acc[ai][0][m][1] * rstd, u0 = acc[ai][1][m][0] * rstd, u1 = acc[ai][1][m][1] * rstd;
                const f32x4 e0 = g0 * -1.4426950408889634f, e1 = g1 * -1.4426950408889634f;
                f32x4 x0, x1;
#pragma unroll
                for (int q = 0; q < 4; ++q) { x0[q] = __builtin_amdgcn_exp2f(e0[q]); x1[q] = __builtin_amdgcn_exp2f(e1[q]); }
                x0 = x0 + 1.f; x1 = x1 + 1.f;
                f32x4 r0, r1;
#pragma unroll
                for (int q = 0; q < 4; ++q) { r0[q] = __builtin_amdgcn_rcpf(x0[q]); r1[q] = __builtin_amdgcn_rcpf(x1[q]); }
                const f32x4 y0 = (g0 * u0) * r0, y1 = (g1 * u1) * r1;
                u32x4 w; w.x = pk2(y0[0], y0[1]); w.y = pk2(y0[2], y0[3]); w.z = pk2(y1[0], y1[1]); w.w = pk2(y1[2], y1[3]);
                *(u32x4*)(ACT + (size_t)r * FFH + col0) = w;
            }
    }
};
struct EpiQKV {
    static constexpr bool PERM = true, AFTER_DRAIN = false;
    bf16_t *Qs, *KV; const float* ssq;
    __device__ __forceinline__ void operator()(const f32x4 (&acc)[2][2][4][2], const Unit& u, int wr, int wc, int fr, int fq) const {
        const bool isq = u.pn < 4; bf16_t* base = isq ? Qs : KV; const int ldc = isq ? 1024 : 512;
        const int col0 = (isq ? u.pn : u.pn - 4) * 256 + wc * 32 + 8 * fq; const float s0 = isq ? 0.125f * 1.4426950408889634f : 1.f;
        const int r0 = u.pm * BM + wr * 64 + fr;
        f32x4 pq[2][4];
#pragma unroll
        for (int ai = 0; ai < 2; ++ai)
#pragma unroll
            for (int m = 0; m < 4; ++m) pq[ai][m] = *(const f32x4*)(ssq + (size_t)(r0 + ai * HALF + m * 16) * 16 + 4 * fq);
        __builtin_amdgcn_sched_barrier(0);
        float rsv[2][4];
#pragma unroll
        for (int ai = 0; ai < 2; ++ai)
#pragma unroll
            for (int m = 0; m < 4; ++m) rsv[ai][m] = rstd_of(pq[ai][m]);
        __builtin_amdgcn_sched_barrier(0);
#pragma unroll
        for (int ai = 0; ai < 2; ++ai)
#pragma unroll
            for (int m = 0; m < 4; ++m) {
                const int r = r0 + ai * HALF + m * 16;
                const float sc = rsv[ai][m] * s0;
                bf16_t* rowp = base + (size_t)r * ldc + col0;
#pragma unroll
                for (int bj = 0; bj < 2; ++bj) { const f32x4 v0 = acc[ai][bj][m][0] * sc, v1 = acc[ai][bj][m][1] * sc;
                    u32x4 w; w.x = pk2(v0[0], v0[1]); w.y = pk2(v0[2], v0[3]); w.z = pk2(v1[0], v1[1]); w.w = pk2(v1[2], v1[3]);
                    *(u32x4*)(rowp + bj * HALF) = w; }
            }
    }
};
}

DI float wave_sum(float v) {
#pragma unroll
    for (int o = 1; o < 64; o <<= 1) v += __shfl_xor(v, o);
    return v;
}
struct TItem { const float* W; bf16_t* WT; const float* gain; int K, N, row_off, mode, item; };
DI void t_load(const TItem& d, int lane, f32x4 (&wv)[8]) {
    const int nblk = d.N / 32, kb = d.item / nblk, nb = d.item % nblk, k0 = 64 * kb, n0 = 32 * nb;
#pragma unroll
    for (int i = 0; i < 8; ++i) wv[i] = *(const f32x4*)(d.W + (size_t)(k0 + 8 * i + (lane >> 3)) * d.N + n0 + 4 * (lane & 7));
}
DI void t_finish(const TItem& d, const f32x4 (&wv)[8], LAS float* scr, int lane) {
    const int nblk = d.N / 32, kb = d.item / nblk, nb = d.item % nblk, k0 = 64 * kb, n0 = 32 * nb;
#pragma unroll
    for (int i = 0; i < 8; ++i) { const int kk = 8 * i + (lane >> 3); const float gsc = d.gain ? d.gain[k0 + kk] : 1.f; LAS float* p = scr + kk * 33 + 4 * (lane & 7);
        p[0] = wv[i].x * gsc; p[1] = wv[i].y * gsc; p[2] = wv[i].z * gsc; p[3] = wv[i].w * gsc; }
    asm volatile("s_waitcnt lgkmcnt(0)" ::: "memory");
    int row0 = d.row_off + n0;
    if (d.mode == 1) row0 = d.row_off + (n0 < FFH ? 256 * (n0 >> 7) + (n0 & 127) : 256 * ((n0 - FFH) >> 7) + 128 + ((n0 - FFH) & 127));
    const int c = lane & 7;
#pragma unroll
    for (int j = 0; j < 4; ++j) { const int n = (lane >> 3) + 8 * j; const LAS float* q = scr + (8 * c) * 33 + n;
        u32x4 o; o.x = pk2(q[0 * 33], q[1 * 33]); o.y = pk2(q[2 * 33], q[3 * 33]); o.z = pk2(q[4 * 33], q[5 * 33]); o.w = pk2(q[6 * 33], q[7 * 33]);
        *(u32x4*)(d.WT + (size_t)(row0 + n) * d.K + k0 + 8 * c) = o; }
    asm volatile("s_waitcnt lgkmcnt(0)" ::: "memory");
}

struct Args { const float* in[14]; float* out; unsigned char* ws; int nseq; unsigned char seq[124]; };

DI void prologue(LAS unsigned char* lds, int gw, int NGW, int wave, int lane) {
    unsigned char* const ws_ = KWS;
    LAS float* scr = (LAS float*)(lds + wave * 16384);
    bf16_t* WT = (bf16_t*)(ws_ + WS_WT);
    const float *mixn = KIN(2), *ffnn = KIN(3), *rwin = KIN(4), *rwout = KIN(5), *kvn = KIN(6), *kvw = KIN(7), *wq = KIN(8), *wo = KIN(9), *fwi = KIN(11), *fwo = KIN(12);
    constexpr int I_WIN = 16 * 192, I_WOUT = 32 * 32, I_FFI = 16 * 176, I_FFO = 44 * 32, I_Q = 16 * 32, I_KV = 16 * 16;
    constexpr int NITEMS = 2 * I_WIN + 2 * I_WOUT + 4 * I_FFI + 4 * I_FFO + 2 * I_Q + I_KV + 2 * I_Q;
#define T_DECODE(it_, d_) do { int r_ = (it_); \
        if (r_ < 2 * I_WIN) { const int l_ = r_ / I_WIN; d_ = TItem{rwin + (size_t)l_ * 1024 * 6144, WT + WO_WIN + (size_t)l_ * 6291456, mixn + l_ * 1024, 1024, 6144, 0, 0, r_ % I_WIN}; break; } r_ -= 2 * I_WIN; \
        if (r_ < 2 * I_WOUT) { const int l_ = r_ / I_WOUT; d_ = TItem{rwout + (size_t)l_ * 2048 * 1024, WT + WO_WOUT + (size_t)l_ * 2097152, nullptr, 2048, 1024, 0, 0, r_ % I_WOUT}; break; } r_ -= 2 * I_WOUT; \
        if (r_ < 4 * I_FFI) { const int l_ = r_ / I_FFI; d_ = TItem{fwi + (size_t)l_ * 1024 * 5632, WT + WO_FFI + (size_t)l_ * 5767168, ffnn + l_ * 1024, 1024, 5632, 0, 1, r_ % I_FFI}; break; } r_ -= 4 * I_FFI; \
        if (r_ < 4 * I_FFO) { const int l_ = r_ / I_FFO; d_ = TItem{fwo + (size_t)l_ * 2816 * 1024, WT + WO_FFO + (size_t)l_ * 2883584, nullptr, 2816, 1024, 0, 0, r_ % I_FFO}; break; } r_ -= 4 * I_FFO; \
        if (r_ < I_Q) { d_ = TItem{wq, WT + WO_QKV2, mixn + 2 * 1024, 1024, 1024, 0, 0, r_}; break; } r_ -= I_Q; \
        if (r_ < I_KV) { d_ = TItem{kvw, WT + WO_QKV2, kvn, 1024, 512, 1024, 0, r_}; break; } r_ -= I_KV; \
        if (r_ < I_Q) { d_ = TItem{wq + (size_t)1024 * 1024, WT + WO_Q3, mixn + 3 * 1024, 1024, 1024, 0, 0, r_}; break; } r_ -= I_Q; \
        { const int l_ = r_ / I_Q; d_ = TItem{wo + (size_t)l_ * 1024 * 1024, WT + WO_WO + (size_t)l_ * 1048576, nullptr, 1024, 1024, 0, 0, r_ % I_Q}; } } while (0)
    {
        int it = gw; TItem cur{}; f32x4 wc[8];
        if (it < NITEMS) { T_DECODE(it, cur); t_load(cur, lane, wc); }
        while (it < NITEMS) {
            const int nx = it + NGW; TItem nd{}; f32x4 wn[8];
            if (nx < NITEMS) { T_DECODE(nx, nd); t_load(nd, lane, wn); }
            t_finish(cur, wc, scr, lane);
            cur = nd;
#pragma unroll
            for (int i = 0; i < 8; ++i) wc[i] = wn[i];
            it = nx;
        }
    }
#undef T_DECODE
    const float* x = KIN(0); const float* meta = KIN(1);
    bf16_t* HB = (bf16_t*)(ws_ + WS_HB); float* ssq = (float*)(ws_ + WS_SSQ);
    for (int m = gw; m < MREAL + 32; m += NGW) {
        u32x2 v[4]; float s = 0.f;
        const bool real = m < MREAL, ismeta = !real && (m - MREAL) < 16;
        const f32x4* src = (const f32x4*)(real ? x + (size_t)m * DM : meta + (size_t)(ismeta ? m - MREAL : 0) * DM) + lane;
#pragma unroll
        for (int j = 0; j < 4; ++j) { const f32x4 t = (real || ismeta) ? src[64 * j] : (f32x4){0.f, 0.f, 0.f, 0.f}; v[j].x = pk2(t.x, t.y); v[j].y = pk2(t.z, t.w);
            s += (bflo(v[j].x) * bflo(v[j].x) + bfhi(v[j].x) * bfhi(v[j].x)) + (bflo(v[j].y) * bflo(v[j].y) + bfhi(v[j].y) * bfhi(v[j].y)); }
        s = wave_sum(s);
        u32x2* o8 = (u32x2*)(HB + (size_t)m * DM) + lane;
#pragma unroll
        for (int j = 0; j < 4; ++j) o8[64 * j] = v[j];
        if (lane < 16) ssq[(size_t)m * 16 + lane] = lane == 0 ? s : 0.f;
    }
}

DI void final_norm(int gw, int NGW, int lane) {
    unsigned char* const ws_ = KWS;
    const float* ssq = (const float*)(ws_ + WS_SSQ); const f32x4* gn = (const f32x4*)KIN(13) + lane; float* const out_ = KOUT; const bf16_t* HB = (const bf16_t*)(ws_ + WS_HB);
    for (int m = gw; m < MREAL; m += NGW) {
        const float rstd = row_rstd(ssq, m);
        f32x4* p = (f32x4*)(out_ + (size_t)m * DM) + lane; const u32x2* hb = (const u32x2*)(HB + (size_t)m * DM) + lane;
#pragma unroll
        for (int j = 0; j < 4; ++j) { const u32x2 h = hb[64 * j]; const f32x4 g = gn[64 * j];
            p[64 * j] = (f32x4){bflo(h.x) * rstd * g.x, bfhi(h.x) * rstd * g.y, bflo(h.y) * rstd * g.z, bfhi(h.y) * rstd * g.w}; }
    }
}

DI size_t ret_row(int b, int n, int s) { return n == 0 ? (size_t)(s >= 112 ? MREAL + s - 112 : MREAL + 16 + (s & 15)) : (size_t)(b * 4096 + (n - 1) * 128 + s); }
DI size_t frag_off(int b, int n, int t, int h, int r, int hh) {
    int tile, rr;
    if (n == 0) { tile = 1024; rr = (t == 3) ? ((r + 16) & 31) : (16 + (r & 15)); } else { tile = b * 128 + (n - 1) * 4 + t; rr = r; }
    return ((size_t)((tile * 4 + h) * 16) * 64 + hh * 32 + rr) * 8;
}
DI bf16x8 trfrag(LAS const unsigned char* p, int rowstride4) {
    const v4i16_t lo = __builtin_amdgcn_ds_read_tr16_b64_v4i16((LAS v4i16_t*)p);
    const v4i16_t hi = __builtin_amdgcn_ds_read_tr16_b64_v4i16((LAS v4i16_t*)(p + rowstride4));
    return __builtin_shufflevector(lo, hi, 0, 1, 2, 3, 4, 5, 6, 7);
}
#define LDS_BARRIER() asm volatile("s_waitcnt lgkmcnt(0)\n\ts_barrier" ::: "memory")
DI void p_phase(LAS unsigned char* lds, const bf16_t* Q, const bf16_t* K, bf16_t* P, bf16_t* KT, int vcu, int G, int w, int lane) {
    constexpr int KRS = 544;
    const int r = lane & 31, hh = lane >> 5, jc = w >> 1, i16 = lane & 15, q4 = i16 >> 2, p4 = i16 & 3, blk = (lane >> 4) & 1;
    const unsigned k_tr = (8 * hh + q4) * KRS + (32 * w + 16 * blk + 4 * p4) * 2;
    const unsigned k_st = r * KRS + hh * 16 + w * 32;
    for (int it = vcu; it < 1028; it += G) {
        int b, h, n; if (it < 1024) { b = it >> 7; h = (it >> 5) & 3; n = 1 + (it & 31); } else { b = 0; h = it - 1024; n = 0; }
        const size_t item = (size_t)((b * 4 + h) * 33 + n);
        bf16_t* Pit = P + item * 16384;
        u32x4 kv[8];
#pragma unroll
        for (int i = 0; i < 8; ++i) kv[i] = *(const u32x4*)(K + frag_off(b, n, i >> 1, h, r, hh) + (size_t)((i & 1) * 8 + w) * 512);
        {
            const int st0 = w & 1, st1 = st0 + 2; const bool has0 = st0 <= jc, has1 = st1 <= jc;
            const bool live0 = has0 && (n > 0 || (st0 == 3 && jc == 3)), live1 = has1 && (n > 0 || (st1 == 3 && jc == 3));
            const bf16_t* qa = Q + frag_off(b, n, jc, h, r, hh);
            const bf16_t* ka0 = K + frag_off(b, n, st0, h, r, hh);
            const bf16_t* ka1 = K + frag_off(b, n, has1 ? st1 : st0, h, r, hh);
            f32x16 acc0, acc1; for (int i = 0; i < 16; ++i) { acc0[i] = 0.f; acc1[i] = 0.f; }
            if (live0 || live1) {
#pragma unroll
                for (int hf = 0; hf < 2; ++hf) {
                    bf16x8 qf[8], a0[8], a1[8];
#pragma unroll
                    for (int ks = 0; ks < 8; ++ks) { qf[ks] = *(const bf16x8*)(qa + 512 * (8 * hf + ks)); if (live0) a0[ks] = *(const bf16x8*)(ka0 + 512 * (8 * hf + ks)); if (live1) a1[ks] = *(const bf16x8*)(ka1 + 512 * (8 * hf + ks)); }
#pragma unroll
                    for (int ks = 0; ks < 8; ++ks) { if (live0) acc0 = MFMA32(a0[ks], qf[ks], acc0); if (live1) acc1 = MFMA32(a1[ks], qf[ks], acc1); }
                }
            }
            const int c = 32 * jc + r;
#pragma unroll
            for (int tl = 0; tl < 2; ++tl) { const int st = tl ? st1 : st0; const f32x16 acc = tl ? acc1 : acc0;
                if (tl ? has1 : has0) {
#pragma unroll
                    for (int g = 0; g < 4; ++g) { const int s0 = 32 * st + 8 * g + 4 * hh;
                        const float v0 = (s0 + 0 <= c) ? acc[4 * g + 0] : 0.f, v1 = (s0 + 1 <= c) ? acc[4 * g + 1] : 0.f, v2 = (s0 + 2 <= c) ? acc[4 * g + 2] : 0.f, v3 = (s0 + 3 <= c) ? acc[4 * g + 3] : 0.f;
                        u32x2 wv; wv.x = pk2(v0, v1); wv.y = pk2(v2, v3);
                        *(u32x2*)(Pit + ((size_t)((jc * 8 + 2 * st + (g >> 1)) * 64) + (g & 1) * 32 + r) * 8 + 4 * hh) = wv; }
                }
            }
        }
#pragma unroll
        for (int i = 0; i < 8; ++i) *(LAS u32x4*)(lds + k_st + (i >> 1) * 32 * KRS + (i & 1) * 256) = kv[i];
        LDS_BARRIER();
        bf16_t* kt = KT + ((item * 8 + w) * 8) * 512 + (size_t)lane * 8;
#pragma unroll
        for (int ks = 0; ks < 8; ++ks) { const bf16x8 kf = trfrag(lds + k_tr + ks * 16 * KRS, 4 * KRS); *(bf16x8*)(kt + 512 * ks) = kf; }
        LDS_BARRIER();
    }
}
template <bool OROLE>
DI void scan_role(LAS unsigned char* lds, const bf16_t* Q, const bf16_t* KT, bf16_t* VO, bf16_t* Ometa, const bf16_t* P, float* stats, int vcu, int G, int tid, int lane, int w) {
    constexpr int VRS = 160, SRS = 528, VS_OFF = 0, VS_SZ = 128 * VRS, ST_OFF = VS_OFF + 2 * VS_SZ, ST_SZ = 64 * SRS;
    static_assert(ST_OFF + 2 * ST_SZ <= 131072, "scan LDS");
    const int r = lane & 31, hh = lane >> 5, i16 = lane & 15, q4 = i16 >> 2, p4 = i16 & 3, blk = (lane >> 4) & 1;
    const int jc = w & 3, nks = 2 * jc + 2;
    const unsigned v_tr = VS_OFF + (8 * hh + q4) * VRS + (16 * blk + 4 * p4) * 2;
    const unsigned s_rd = ST_OFF + r * SRS + 16 * hh;
    const unsigned s_wr = ST_OFF + r * SRS + (64 * jc + 4 * hh) * 2;
    const unsigned v_st = VS_OFF + (tid >> 3) * VRS + (tid & 7) * 16;
    const unsigned lp_reg = (unsigned)lane * 8u;
    for (int it = vcu; it < 256; it += G) {
        const int b = it >> 5, h = (it >> 3) & 3, j = it & 7;
        const float l2g = head_l2g(h), gam = 1.f - __builtin_amdgcn_exp2f(-5.f - (float)h), gC1 = __builtin_amdgcn_exp2f(127.f * l2g);
        f32x16 z16; for (int i = 0; i < 16; ++i) z16[i] = 0.f;
        f32x16 acc[OROLE ? 2 : 4];
#pragma unroll
        for (int t = 0; t < (OROLE ? 2 : 4); ++t) acc[t] = z16;
        const bf16_t* vb = VO + h * 512 + 64 * j + (tid & 7) * 8;
#define SC_ITEM(n_) ((size_t)((((n_) == 0 ? 0 : b) * 4 + h) * 33 + (n_)))
#define SC_KT(n_) (KT + ((SC_ITEM(n_) * 8 + 2 * jc) * 8) * 512 + lp_reg)
#define SC_P(n_) (P + SC_ITEM(n_) * 16384 + (size_t)(jc * 8 * 64) * 8 + lp_reg)
#define SC_Q(n_) (Q + ((size_t)((b * 128 + ((n_) - 1) * 4 + jc) * 4 + h) * 16) * 512 + lp_reg)
        bf16x8 fr[OROLE ? 24 : 16]; u32x4 vv[2];
#pragma unroll
        for (int i = 0; i < 2; ++i) vv[i] = *(const u32x4*)(vb + ret_row(b, 0, (tid >> 3) + 64 * i) * 2048);
        if constexpr (OROLE) { const bf16_t* pa = SC_P(0);
#pragma unroll
            for (int ks = 0; ks < 8; ++ks) if (ks < nks) fr[16 + ks] = *(const bf16x8*)(pa + 512 * ks);
        } else { const bf16_t* kt = SC_KT(0);
#pragma unroll
            for (int ks = 0; ks < 16; ++ks) fr[ks] = *(const bf16x8*)(kt + 512 * ks); }
#pragma unroll
        for (int i = 0; i < 2; ++i) *(LAS u32x4*)(lds + v_st + i * 64 * VRS) = vv[i];
        { int t3 = tid >> 3; asm volatile("" : "+v"(t3));
#pragma unroll
          for (int i = 0; i < 2; ++i) vv[i] = *(const u32x4*)(vb + ret_row(b, 1, t3 + 64 * i) * 2048); }
        LDS_BARRIER();
        for (int n = 0; n < 33; ++n) {
            const bool more = n < 32;
            const unsigned cv = (unsigned)(n & 1) * VS_SZ, nv = VS_SZ - cv, cs = (unsigned)(n & 1) * ST_SZ, ns = ST_SZ - cs;
            if constexpr (OROLE) {
                const bf16_t* pan = SC_P(n + 1); const bf16_t* qan = SC_Q(n + 1);
                acc[0] = z16; acc[1] = z16;
#pragma unroll
                for (int ks = 0; ks < 8; ++ks) if (ks < nks) {
                    const bf16x8 vf0 = trfrag(lds + v_tr + cv + ks * 16 * VRS, 4 * VRS);
                    const bf16x8 vf1 = trfrag(lds + v_tr + cv + ks * 16 * VRS + 64, 4 * VRS);
                    acc[0] = MFMA32(vf0, fr[16 + ks], acc[0]); acc[1] = MFMA32(vf1, fr[16 + ks], acc[1]);
                    if (more) fr[16 + ks] = *(const bf16x8*)(pan + 512 * ks);
                    __builtin_amdgcn_sched_barrier(0);
                }
                if (n > 0) {
#pragma unroll
                    for (int ks = 0; ks < 16; ++ks) { const bf16x8 a0 = *(const LAS bf16x8*)(lds + s_rd + cs + ks * 32); const bf16x8 a1 = *(const LAS bf16x8*)(lds + s_rd + cs + 32 * SRS + ks * 32);
                        acc[0] = MFMA32(a0, fr[ks], acc[0]); acc[1] = MFMA32(a1, fr[ks], acc[1]);
                        if (more) fr[ks] = *(const bf16x8*)(qan + 512 * ks);
                        if ((ks & 3) == 3) __builtin_amdgcn_sched_barrier(0); }
                } else {
#pragma unroll
                    for (int ks = 0; ks < 16; ++ks) fr[ks] = *(const bf16x8*)(qan + 512 * ks);
                }
                if (n > 0 || b == 0) {
                    int r_l = r; asm volatile("" : "+v"(r_l));
                    const size_t row = ret_row(b, n, 32 * jc + r_l);
                    bf16_t* dst = (n == 0 ? Ometa + (row - MREAL) * 2048 : VO + row * 2048) + h * 512 + 64 * j + 4 * hh;
                    float s1 = 0.f, s2 = 0.f;
#pragma unroll
                    for (int t = 0; t < 2; ++t)
#pragma unroll
                        for (int g = 0; g < 4; ++g) { const f32x16 o = acc[t]; u32x2 wv; wv.x = pk2(o[4 * g], o[4 * g + 1]); wv.y = pk2(o[4 * g + 2], o[4 * g + 3]); *(u32x2*)(dst + 32 * t + 8 * g) = wv;
                            s1 += (o[4 * g] + o[4 * g + 1]) + (o[4 * g + 2] + o[4 * g + 3]);
                            s2 += (o[4 * g] * o[4 * g] + o[4 * g + 1] * o[4 * g + 1]) + (o[4 * g + 2] * o[4 * g + 2] + o[4 * g + 3] * o[4 * g + 3]); }
                    s1 += __shfl_xor(s1, 32); s2 += __shfl_xor(s2, 32);
                    if (hh == 0) { const f32x4 sv = {s1, s2, 0.f, 0.f}; *(f32x4*)(stats + ((row * 4 + h) * 16 + 2 * j) * 2) = sv; }
                }
            } else {
                const bf16_t* ktn = SC_KT(n + 1);
#pragma unroll
                for (int t = 0; t < 4; ++t) acc[t] = acc[t] * gam;
#pragma unroll
                for (int ks = 0; ks < 8; ++ks) {
                    const bf16x8 vf0 = trfrag(lds + v_tr + cv + ks * 16 * VRS, 4 * VRS);
                    const bf16x8 vf1 = trfrag(lds + v_tr + cv + ks * 16 * VRS + 64, 4 * VRS);
                    acc[0] = MFMA32(fr[ks], vf0, acc[0]); acc[1] = MFMA32(fr[ks], vf1, acc[1]);
                    acc[2] = MFMA32(fr[8 + ks], vf0, acc[2]); acc[3] = MFMA32(fr[8 + ks], vf1, acc[3]);
                    if (more) { fr[ks] = *(const bf16x8*)(ktn + 512 * ks); fr[8 + ks] = *(const bf16x8*)(ktn + 512 * (8 + ks)); }
                    __builtin_amdgcn_sched_barrier(0);
                }
#pragma unroll
                for (int t = 0; t < 4; ++t) acc[t] = acc[t] * gC1;
            }
            if constexpr (!OROLE) {
#pragma unroll
                for (int t = 0; t < 4; ++t)
#pragma unroll
                    for (int g = 0; g < 4; ++g) { u32x2 a; a.x = pk2(acc[t][4 * g] * gam, acc[t][4 * g + 1] * gam); a.y = pk2(acc[t][4 * g + 2] * gam, acc[t][4 * g + 3] * gam);
                        *(LAS u32x2*)(lds + s_wr + ns + (t & 1) * 32 * SRS + (t >> 1) * 64 + g * 16) = a; }
            }
            if (more) {
#pragma unroll
                for (int i = 0; i < 2; ++i) *(LAS u32x4*)(lds + v_st + nv + i * 64 * VRS) = vv[i];
                if (n + 2 < 33) { int t3 = tid >> 3; asm volatile("" : "+v"(t3));
#pragma unroll
                    for (int i = 0; i < 2; ++i) vv[i] = *(const u32x4*)(vb + ret_row(b, n + 2, t3 + 64 * i) * 2048); }
            }
            LDS_BARRIER();
        }
#undef SC_ITEM
#undef SC_KT
#undef SC_P
#undef SC_Q
        LDS_BARRIER();
    }
}
DI void scan_phase(LAS unsigned char* lds, const bf16_t* Q, const bf16_t* KT, bf16_t* VO, bf16_t* Ometa, const bf16_t* P, float* stats, int vcu, int G) {
    int tid_s = threadIdx.x; asm volatile("" : "+v"(tid_s));
    const int tid = tid_s, lane = tid & 63, w = __builtin_amdgcn_readfirstlane(tid >> 6);
    if (w < 4) scan_role<true>(lds, Q, KT, VO, Ometa, P, stats, vcu, G, tid, lane, w);
    else scan_role<false>(lds, Q, KT, VO, Ometa, P, stats, vcu, G, tid, lane, w);
    asm volatile("s_waitcnt vmcnt(0)" ::: "memory");
}

template <bool FIRST>
DI void attn_task(LAS unsigned char* lds, const bf16_t* Qs, bf16_t* AO, float slope2, float sink2, size_t qrow, int head, int rb, int nb, int r, int hh, int q4, int p4, int blk) {
    constexpr int RS = 144, K_OFF = 0, V_OFF = 288 * RS;
    bf16x8 qf[4];
#pragma unroll
    for (int ks = 0; ks < 4; ++ks) qf[ks] = *(const bf16x8*)(Qs + qrow * 1024 + head * 64 + 16 * ks + 8 * hh);
    const int rq = 32 * rb + r, lim1 = FIRST ? rq : 127, D0 = 128 + r - 4 * hh;
    const float cst = slope2 * (float)(128 + r), h4 = slope2 * (float)(4 * hh), dm = slope2 * (float)(nb * 128 + 32 * rb - 112), sinkp = sink2 + cst;
#define ATT_TILE(t, st, init) do { const int rowbase_ = (t) == 0 ? 0 : 32 + 32 * (rb + (t) - 1); { const float in_ = (init); for (int i_ = 0; i_ < 16; ++i_) st[i_] = in_; } \
        int D0_ = D0; asm volatile("" : "+v"(D0_)); \
        _Pragma("unroll") for (int ks = 0; ks < 4; ++ks) { const bf16x8 a_ = *(const LAS bf16x8*)(lds + K_OFF + (rowbase_ + r) * RS + (16 * ks + 8 * hh) * 2); st = MFMA32(a_, qf[ks], st); } \
        _Pragma("unroll") for (int i_ = 0; i_ < 16; ++i_) { const int c_ = (i_ & 3) + 8 * (i_ >> 2); \
            if ((t) == 0) st[i_] = (i_ < 8) ? __builtin_fmaf(slope2, (float)c_, st[i_]) - dm : -INFINITY; \
            else { float v_ = __builtin_fmaf(slope2, (float)(32 * ((t) - 1) + c_), st[i_]); \
                if (FIRST || (t) == 1 || (t) == 5) { const int dist_ = D0_ - 32 * ((t) - 1) - c_; const unsigned bnd_ = ((unsigned)(dist_ | (lim1 - dist_)) & 0x80000000u) | 0x7f800000u; v_ = fminf(v_, __builtin_bit_cast(float, bnd_)); } \
                st[i_] = v_; } } } while (0)
    float m = sinkp, l = 0.f;
    f32x16 o0, o1; for (int i = 0; i < 16; ++i) { o0[i] = 0.f; o1[i] = 0.f; }
#pragma unroll
    for (int t = 0; t < 6; ++t) { const int rowbase = t == 0 ? 0 : 32 + 32 * (rb + t - 1);
        f32x16 st; ATT_TILE(t, st, h4);
        float tm = fmaxf(fmaxf(st[0], st[1]), fmaxf(st[2], st[3]));
#pragma unroll
        for (int i = 4; i < 16; i += 4) tm = fmaxf(tm, fmaxf(fmaxf(st[i], st[i + 1]), fmaxf(st[i + 2], st[i + 3])));
        tm = fmaxf(tm, __shfl_xor(tm, 32));
        const float mn = fmaxf(m, tm), sc = __builtin_amdgcn_exp2f(m - mn);
        m = mn;
        if (__any(sc != 1.f)) { l *= sc; o0 = o0 * sc; o1 = o1 * sc; }
#pragma unroll
        for (int i = 0; i < 16; ++i) { const float e = __builtin_amdgcn_exp2f(st[i] - mn); st[i] = e; l += e; }
#pragma unroll
        for (int ss = 0; ss < 2; ++ss) {
            u32x4 pw; pw.x = pk2(st[8 * ss], st[8 * ss + 1]); pw.y = pk2(st[8 * ss + 2], st[8 * ss + 3]);
            pw.z = pk2(st[8 * ss + 4], st[8 * ss + 5]); pw.w = pk2(st[8 * ss + 6], st[8 * ss + 7]);
            const bf16x8 pfrag = __builtin_bit_cast(bf16x8, pw);
            const int rowb = rowbase + 16 * ss + 4 * hh + q4;
            const bf16x8 a0 = trfrag(lds + V_OFF + rowb * RS + (16 * blk + 4 * p4) * 2, 8 * RS);
            const bf16x8 a1 = trfrag(lds + V_OFF + rowb * RS + (32 + 16 * blk + 4 * p4) * 2, 8 * RS);
            o0 = MFMA32(a0, pfrag, o0); o1 = MFMA32(a1, pfrag, o1);
        }
        __builtin_amdgcn_sched_barrier(0); }
#undef ATT_TILE
    float sum = l + __shfl_xor(l, 32); sum += __builtin_amdgcn_exp2f(sinkp - m);
    const float inv = 1.f / sum;
    o0 = o0 * inv; o1 = o1 * inv;
    bf16_t* dst = AO + qrow * 1024 + head * 64 + 4 * hh;
#pragma unroll
    for (int g4 = 0; g4 < 4; ++g4) { u32x2 a; a.x = pk2(o0[4 * g4], o0[4 * g4 + 1]); a.y = pk2(o0[4 * g4 + 2], o0[4 * g4 + 3]); *(u32x2*)(dst + 8 * g4) = a;
        u32x2 c; c.x = pk2(o1[4 * g4], o1[4 * g4 + 1]); c.y = pk2(o1[4 * g4 + 2], o1[4 * g4 + 3]); *(u32x2*)(dst + 32 + 8 * g4) = c; }
}
DI void attn_phase(LAS unsigned char* lds, const bf16_t* Qs, const bf16_t* KV, bf16_t* AO, const float* sinks, int vcu, int G, int w, int lane, int tid) {
    constexpr int RS = 144, K_OFF = 0, V_OFF = 288 * RS;
    constexpr float LOG2E = 1.4426950408889634f;
    const int r = lane & 31, hh = lane >> 5, i16 = lane & 15, q4 = i16 >> 2, p4 = i16 & 3, blk = (lane >> 4) & 1;
    for (int un = vcu; un < 1024; un += G) {
        const int b = un >> 7, kvh = (un >> 5) & 3, nb = un & 31;
        __syncthreads();
        for (int idx = tid; idx < 2304; idx += 512) { const int row = idx >> 3, ch = idx & 7;
            size_t grow; if (row < 32) grow = (size_t)MREAL + row; else { const int c = row - 32, t = nb * 128 - 128 + c; grow = t < 0 ? (size_t)(MREAL + 16 + (c & 15)) : (size_t)(b * 4096 + t); }
            const u32x4 kk = *(const u32x4*)(KV + grow * 512 + kvh * 64 + ch * 8), vv = *(const u32x4*)(KV + grow * 512 + 256 + kvh * 64 + ch * 8);
            *(LAS u32x4*)(lds + K_OFF + row * RS + ch * 16) = kk; *(LAS u32x4*)(lds + V_OFF + row * RS + ch * 16) = vv; }
        __syncthreads();
#pragma unroll 1
        for (int tt = 0; tt < 2; ++tt) {
            const int task = w * 2 + tt, g = task >> 2, rb = task & 3, head = kvh * 4 + g;
            const float slope2 = exp2f(-0.5f * (float)(head + 1)) * LOG2E, sink2 = sinks[head] * LOG2E;
            const size_t qrow = (size_t)b * 4096 + nb * 128 + 32 * rb + r;
            if (nb == 0) attn_task<true>(lds, Qs, AO, slope2, sink2, qrow, head, rb, nb, r, hh, q4, p4, blk);
            else attn_task<false>(lds, Qs, AO, slope2, sink2, qrow, head, rb, nb, r, hh, q4, p4, blk);
        }
    }
}


DI void skinny_phase(LAS unsigned char* lds, int kind, const bf16_t* A, const bf16_t* Bt, int K, unsigned char* ws, int vcu, int G, int w, int lane) {
    const int r = lane & 31, hh = lane >> 5;
    const int ntask = kind == 1 ? 128 : (kind == 4 ? 64 : (kind == 5 ? 16 : (kind == 6 ? 88 : 16)));
    const float* ssq = (const float*)(ws + WS_SSQ);
    LAS float* red = (LAS float*)lds;
    for (int task = vcu; task < ntask; task += G) {
        int nb0, nb1;
        if (kind == 5) { nb0 = 64 * task; nb1 = nb0 + 32; }
        else if (kind == 6) { nb0 = 256 * (task >> 2) + 32 * (task & 3); nb1 = nb0 + 128; }
        else if (kind == 7) { nb0 = 1024 + 32 * task; nb1 = nb0; }
        else { nb0 = 32 * task; nb1 = nb0; }
        const bool two = (kind == 5 || kind == 6);
        const int nks = K >> 7;
        const bf16_t* pa0 = Bt + (size_t)(nb0 + r) * K + w * (K >> 3) + 8 * hh;
        const bf16_t* pa1 = Bt + (size_t)(nb1 + r) * K + w * (K >> 3) + 8 * hh;
        const bf16_t* pb = A + (size_t)(MREAL + r) * K + w * (K >> 3) + 8 * hh;
        f32x16 acc0, acc1; for (int i = 0; i < 16; ++i) { acc0[i] = 0.f; acc1[i] = 0.f; }
#pragma unroll 8
        for (int ks = 0; ks < nks; ++ks) { const bf16x8 bx = *(const bf16x8*)(pb + 16 * ks); const bf16x8 a0 = *(const bf16x8*)(pa0 + 16 * ks); acc0 = MFMA32(a0, bx, acc0);
            if (two) { const bf16x8 a1 = *(const bf16x8*)(pa1 + 16 * ks); acc1 = MFMA32(a1, bx, acc1); } }
#pragma unroll
        for (int i = 0; i < 16; ++i) { red[((w * 2 + 0) * 16 + i) * 64 + lane] = acc0[i]; red[((w * 2 + 1) * 16 + i) * 64 + lane] = acc1[i]; }
        __syncthreads();
        if (w == 0) {
#pragma unroll
            for (int i = 0; i < 16; ++i) { float s0 = 0.f, s1 = 0.f;
#pragma unroll
                for (int ww = 0; ww < 8; ++ww) { s0 += red[((ww * 2 + 0) * 16 + i) * 64 + lane]; s1 += red[((ww * 2 + 1) * 16 + i) * 64 + lane]; }
                acc0[i] = s0; acc1[i] = s1; }
            const int row = MREAL + r; const float rstd = row_rstd(ssq, row);
            if (kind == 1) {
                const int pn = nb0 >> 8, kd = pn < 4 ? 0 : (pn < 8 ? 1 : 2), head = pn & 3;
                const float l2g = head_l2g(head), sgn = kd == 0 ? l2g : (kd == 1 ? -l2g : 0.f);
                const float sc = rstd * (kd == 0 ? 0.0625f : 1.f) * __builtin_amdgcn_exp2f(sgn * (float)((r + 112) & 127));
                bf16_t* base = (bf16_t*)(ws + WS_Q + (size_t)kd * (65 * MiB)); const int cb = nb0 & 255;
#pragma unroll
                for (int g = 0; g < 4; ++g) { u32x2 wv; wv.x = pk2(acc0[4 * g] * sc, acc0[4 * g + 1] * sc); wv.y = pk2(acc0[4 * g + 2] * sc, acc0[4 * g + 3] * sc);
                    const int c = cb + 8 * g;
                    bf16_t* dst = kd == 2 ? base + (size_t)row * 2048 + (nb0 - 2048) + 8 * g + 4 * hh : base + ((size_t)((1024 * 4 + head) * 16 + (c >> 4)) * 64 + ((c >> 3) & 1) * 32 + r) * 8 + 4 * hh;
                    *(u32x2*)dst = wv; }
            } else if (kind == 4) {
                const int head = nb0 >> 9; const f32x4* sp = (const f32x4*)((const float*)(ws + WS_STATS) + ((size_t)row * 4 + head) * 32);
                float s1 = 0.f, s2 = 0.f;
#pragma unroll
                for (int t = 0; t < 8; ++t) { const f32x4 v = sp[t]; s1 += v.x + v.z; s2 += v.y + v.w; }
                const float mu = s1 * (1.f / 512.f); float var = s2 * (1.f / 512.f) - mu * mu; var = var > 0.f ? var : 0.f; const float rs = rsqrtf(var + 1e-6f);
                const bf16_t* osrc = (const bf16_t*)(ws + WS_OMETA) + (size_t)r * 2048 + nb0 + 4 * hh; bf16_t* dst = (bf16_t*)(ws + WS_VO) + (size_t)row * 2048 + nb0 + 4 * hh;
#pragma unroll
                for (int g = 0; g < 4; ++g) { const u32x2 ov = *(const u32x2*)(osrc + 8 * g); u32x2 wv;
                    wv.x = pk2(siluf(acc0[4 * g] * rstd) * (bflo(ov.x) - mu) * rs, siluf(acc0[4 * g + 1] * rstd) * (bfhi(ov.x) - mu) * rs);
                    wv.y = pk2(siluf(acc0[4 * g + 2] * rstd) * (bflo(ov.y) - mu) * rs, siluf(acc0[4 * g + 3] * rstd) * (bfhi(ov.y) - mu) * rs); *(u32x2*)(dst + 8 * g) = wv; }
            } else if (kind == 5) {
                bf16_t* brow = (bf16_t*)(ws + WS_HB) + (size_t)row * DM + 4 * hh; float ss = 0.f;
#pragma unroll
                for (int g = 0; g < 4; ++g) {
                    const u32x2 o0 = *(const u32x2*)(brow + nb0 + 8 * g), o1 = *(const u32x2*)(brow + nb1 + 8 * g);
                    u32x2 w0; w0.x = pk2(bflo(o0.x) + acc0[4 * g], bfhi(o0.x) + acc0[4 * g + 1]); w0.y = pk2(bflo(o0.y) + acc0[4 * g + 2], bfhi(o0.y) + acc0[4 * g + 3]); *(u32x2*)(brow + nb0 + 8 * g) = w0;
                    u32x2 w1; w1.x = pk2(bflo(o1.x) + acc1[4 * g], bfhi(o1.x) + acc1[4 * g + 1]); w1.y = pk2(bflo(o1.y) + acc1[4 * g + 2], bfhi(o1.y) + acc1[4 * g + 3]); *(u32x2*)(brow + nb1 + 8 * g) = w1;
                    ss += (bflo(w0.x) * bflo(w0.x) + bfhi(w0.x) * bfhi(w0.x)) + (bflo(w0.y) * bflo(w0.y) + bfhi(w0.y) * bfhi(w0.y)) + (bflo(w1.x) * bflo(w1.x) + bfhi(w1.x) * bfhi(w1.x)) + (bflo(w1.y) * bflo(w1.y) + bfhi(w1.y) * bfhi(w1.y)); }
                ss += __shfl_xor(ss, 32);
                if (hh == 0) ((float*)(ws + WS_SSQ))[(size_t)row * 16 + task] = ss;
            } else if (kind == 6) {
                bf16_t* dst = (bf16_t*)(ws + WS_ACT) + (size_t)row * FFH + 128 * (task >> 2) + 32 * (task & 3) + 4 * hh;
#pragma unroll
                for (int g = 0; g < 4; ++g) { u32x2 wv; wv.x = pk2(siluf(acc0[4 * g] * rstd) * (acc1[4 * g] * rstd), siluf(acc0[4 * g + 1] * rstd) * (acc1[4 * g + 1] * rstd));
                    wv.y = pk2(siluf(acc0[4 * g + 2] * rstd) * (acc1[4 * g + 2] * rstd), siluf(acc0[4 * g + 3] * rstd) * (acc1[4 * g + 3] * rstd)); *(u32x2*)(dst + 8 * g) = wv; }
            } else {
                bf16_t* dst = (bf16_t*)(ws + WS_P) + (size_t)row * 512 + 32 * task + 4 * hh;
#pragma unroll
                for (int g = 0; g < 4; ++g) { u32x2 wv; wv.x = pk2(acc0[4 * g] * rstd, acc0[4 * g + 1] * rstd); wv.y = pk2(acc0[4 * g + 2] * rstd, acc0[4 * g + 3] * rstd); *(u32x2*)(dst + 8 * g) = wv; }
            }
        }
        __syncthreads();
    }
}

#define XB_TMO      128
#define XB_XCNT(j)  (256  + 64 * (j))
#define XB_XSUB(j)  (1280 + 64 * (j))
#define XB_XGEN(j)  (2304 + 64 * (j))
#define XB_TOP      3328
#define XB_TOPGEN   3392
#define XCD_BAR_WORDS 3456
#define XB_SPIN_CAP (1u << 18)

__device__ __forceinline__ unsigned xb_ld(unsigned* p)              { return __hip_atomic_load(p, __ATOMIC_RELAXED, __HIP_MEMORY_SCOPE_AGENT); }
__device__ __forceinline__ unsigned xb_add(unsigned* p, unsigned v) { return __hip_atomic_fetch_add(p, v, __ATOMIC_RELAXED, __HIP_MEMORY_SCOPE_AGENT); }
__device__ __forceinline__ unsigned xb_xcc_id() { return (unsigned)__builtin_amdgcn_s_getreg((3 << 11) | 20) & 0xFu; }
#define XB_SPIN(cond, bar) do { unsigned _sp = 0; while (cond) { __builtin_amdgcn_s_sleep(1); \
    if ((++_sp & 255u) == 0u) { if (xb_ld(&(bar)[XB_TMO])) break; if (_sp > XB_SPIN_CAP) { atomicAdd(&(bar)[XB_TMO], 1u); break; } } } } while (0)

struct XcdBarrier {
    unsigned* bar; unsigned x;
    volatile LAS unsigned* st;
};

__device__ __forceinline__ XcdBarrier xcd_barrier_post(unsigned* bar, volatile LAS unsigned* st) {
    XcdBarrier b; b.bar = bar; b.x = xb_xcc_id(); b.st = st;
    if (threadIdx.x == 0) (void)xb_add(&bar[XB_XCNT(b.x)], 1u);
    return b;
}
__device__ __forceinline__ void xcd_barrier_complete(unsigned* bar, unsigned x, unsigned& nloc, unsigned& nx) {
    const unsigned G = gridDim.x * gridDim.y * gridDim.z;
    unsigned sum, cnt, mine, sp = 0u;
    for (;;) {
        sum = 0u; cnt = 0u; mine = 0u;
#pragma unroll
        for (unsigned j = 0; j < 16; ++j) { const unsigned c = xb_ld(&bar[XB_XCNT(j)]); sum += c; cnt += (c > 0u) ? 1u : 0u; mine = (j == x) ? c : mine; }
        if (sum == G) break;
        __builtin_amdgcn_s_sleep(1);
        if ((++sp & 255u) == 0u) { if (xb_ld(&bar[XB_TMO])) break; if (sp > XB_SPIN_CAP) { atomicAdd(&bar[XB_TMO], 1u); break; } }
    }
    nloc = mine > 0u ? mine : 1u; nx = cnt > 0u ? cnt : 1u;
}

__device__ __forceinline__ void xcd_barrier(const XcdBarrier& b) {
    asm volatile("s_waitcnt vmcnt(0)" ::: "memory");
    __syncthreads();
    if (threadIdx.x == 0) {
        unsigned* bar = b.bar;
        __builtin_amdgcn_s_waitcnt(0);
        unsigned nloc = b.st[0], nx = b.st[1];
        if (nloc == 0u) { xcd_barrier_complete(bar, b.x, nloc, nx); b.st[0] = nloc; b.st[1] = nx; }
        const unsigned old = xb_add(&bar[XB_XSUB(b.x)], 1u);
        const unsigned gen = old / nloc;
        if (old + 1u == (gen + 1u) * nloc) {
            __builtin_amdgcn_fence(__ATOMIC_RELEASE, "agent");
            asm volatile("s_waitcnt vmcnt(0)" ::: "memory");
            const unsigned og = xb_add(&bar[XB_TOP], 1u);
            const unsigned tg = og / nx;
            if (og + 1u == (tg + 1u) * nx) xb_add(&bar[XB_TOPGEN], 1u);
            else XB_SPIN(xb_ld(&bar[XB_TOPGEN]) == tg, bar);
            __builtin_amdgcn_fence(__ATOMIC_ACQUIRE, "agent");
            xb_add(&bar[XB_XGEN(b.x)], 1u);
            asm volatile("s_waitcnt vmcnt(0)" ::: "memory");
        } else {
            XB_SPIN(xb_ld(&bar[XB_XGEN(b.x)]) == gen, bar);
            __builtin_amdgcn_fence(__ATOMIC_ACQUIRE, "agent");
            asm volatile("s_waitcnt vmcnt(0)" ::: "memory");
        }
    }
    __syncthreads();
}

constexpr int LDS_BYTES = 147456, NPHASE = 26;
__global__ void __launch_bounds__(512, 2) mk_fwd(Args A) {
    extern __shared__ __attribute__((aligned(16))) unsigned char lds_raw[];
    LAS unsigned char* lds = (LAS unsigned char*)lds_raw;
    const int G = gridDim.x, bx = blockIdx.x, vcu = (G % 8 == 0) ? (bx % 8) * (G / 8) + bx / 8 : bx;
    volatile LAS unsigned* MISC = (volatile LAS unsigned*)(lds + 131072 + 320);
    if (threadIdx.x < 32) MISC[threadIdx.x] = 0u;
    __syncthreads();
    const XcdBarrier bar = xcd_barrier_post((unsigned*)(KWS + WS_CTL) , MISC + 8);
    if (karg_i(128) < 0) cg::this_grid().sync();
    const int nseq = karg_i(128);
    for (int si = 0; si < nseq; ++si) {
        const int ph = karg_b(132 + si);
#define LTW int tid_x = threadIdx.x; asm volatile("" : "+v"(tid_x)); const int tid = tid_x, lane = tid & 63, w = __builtin_amdgcn_readfirstlane(tid >> 6); (void)tid; (void)lane; (void)w;
        unsigned char* ws = KWS;
        bf16_t* WT = (bf16_t*)(ws + WS_WT); float* ssq = (float*)(ws + WS_SSQ); bf16_t* HB = (bf16_t*)(ws + WS_HB);
        bf16_t* Qb = (bf16_t*)(ws + WS_Q); bf16_t* Kb = (bf16_t*)(ws + WS_K); bf16_t* VO = (bf16_t*)(ws + WS_VO); bf16_t* ACT = (bf16_t*)(ws + WS_ACT);
        int kind, l;
        const bf16_t* gA = nullptr; const bf16_t* gB = nullptr; int gM = MREAL, gN = 1024, gK = 1024; bool meta = false;
        if (ph == 0) { kind = 0; l = 0; }
        else if (ph <= 14) { l = (ph - 1) / 7; const int k = (ph - 1) % 7; meta = true;
            if (k == 0) { kind = 1; gA = HB; gB = WT + WO_WIN + (size_t)l * 6291456; gN = 4096; }
            else if (k == 1) kind = 2; else if (k == 2) kind = 3;
            else if (k == 3) { kind = 4; gA = HB; gB = WT + WO_WIN + (size_t)l * 6291456 + (size_t)4096 * 1024; gN = 2048; }
            else if (k == 4) { kind = 5; gA = VO; gB = WT + WO_WOUT + (size_t)l * 2097152; gK = 2048; }
            else if (k == 5) { kind = 6; gA = HB; gB = WT + WO_FFI + (size_t)l * 5767168; gN = 5632; }
            else { kind = 5; gA = ACT; gB = WT + WO_FFO + (size_t)l * 2883584; gK = FFH; } }
        else if (ph <= 24) { l = 2 + (ph - 15) / 5; const int k = (ph - 15) % 5; gM = MREAL;
            if (k == 0) { kind = 7; gA = HB; if (l == 2) { gB = WT + WO_QKV2; gN = 1536; meta = true; } else { gB = WT + WO_Q3; gN = 1024; } }
            else if (k == 1) kind = 8;
            else if (k == 2) { kind = 5; gA = VO; gB = WT + WO_WO + (size_t)(l - 2) * 1048576; }
            else if (k == 3) { kind = 6; gA = HB; gB = WT + WO_FFI + (size_t)l * 5767168; gN = 5632; }
            else { kind = 5; gA = ACT; gB = WT + WO_FFO + (size_t)l * 2883584; gK = FFH; } }
        else if (ph == 25) { kind = 9; l = 0; }
        else { kind = 10; l = 0; }
        pg8::Gemm g{gA, gB, gM, gN, gK}; pg8::StaticOrder S; S.init(gM, gN, G, bx);
        if (meta && (kind == 1 || (kind >= 4 && kind <= 7))) { LTW skinny_phase(lds, kind, gA, gB, gK, ws, vcu, G, w, lane); }
        if (kind == 0) { LTW prologue(lds, vcu * 8 + w, G * 8, w, lane); }
        else if (kind == 1) { pg8::EpiRetIn E{ws, ssq}; pg8::gemm_phase<pg8::EpiRetIn, pg8::StaticOrder, true, true>(lds, g, S, E); }
        else if (kind == 2) { LTW p_phase(lds, Qb, Kb, (bf16_t*)(ws + WS_P), (bf16_t*)KOUT, vcu, G, w, lane); }
        else if (kind == 3) scan_phase(lds, Qb, (const bf16_t*)KOUT, VO, (bf16_t*)(ws + WS_OMETA), (const bf16_t*)(ws + WS_P), (float*)(ws + WS_STATS), vcu, G);
        else if (kind == 4) { pg8::EpiG E{VO, (const bf16_t*)(ws + WS_OMETA), ssq, (const float*)(ws + WS_STATS)}; pg8::gemm_phase<pg8::EpiG, pg8::StaticOrder, true, true>(lds, g, S, E); }
        else if (kind == 5) { pg8::EpiRes E{HB, ssq}; pg8::gemm_phase<pg8::EpiRes, pg8::StaticOrder, true, true>(lds, g, S, E); }
        else if (kind == 6) { pg8::EpiFfnIn E{ACT, ssq}; pg8::gemm_phase<pg8::EpiFfnIn, pg8::StaticOrder, true, true>(lds, g, S, E); }
        else if (kind == 7) { pg8::EpiQKV E{Qb, (bf16_t*)(ws + WS_P), ssq};     pg8::gemm_phase<pg8::EpiQKV, pg8::StaticOrder, true, true>(lds, g, S, E); }
        else if (kind == 8) { LTW attn_phase(lds, Qb, (const bf16_t*)(ws + WS_P), VO, KIN(10) + (l - 2) * 16, vcu, G, w, lane, tid); }
        else if (kind == 9) { LTW final_norm(vcu * 8 + w, G * 8, lane); }
        if (si + 1 < nseq) xcd_barrier(bar);
    }
}

extern "C" void kernel_launch(void* const* d_in, const int* in_sizes, int n_in, void* d_out, int out_size, void* d_ws, size_t ws_size, hipStream_t stream) {
    static int grid = 0;
    if (grid == 0) {
        if (n_in != 14 || out_size != MREAL * DM || ws_size < WS_END) { fprintf(stderr, "kernel_launch: unexpected shapes (n_in %d out %d ws %zu)\n", n_in, out_size, ws_size); grid = -1; return; }
        int dev = 0, cus = 0, per_cu = 0;
        hipGetDevice(&dev); hipDeviceGetAttribute(&cus, hipDeviceAttributeMultiprocessorCount, dev);
        if (hipFuncSetAttribute((const void*)mk_fwd, hipFuncAttributeMaxDynamicSharedMemorySize, LDS_BYTES) != hipSuccess) { fprintf(stderr, "kernel_launch: hipFuncSetAttribute failed\n"); grid = -1; return; }
        if (hipOccupancyMaxActiveBlocksPerMultiprocessor(&per_cu, (const void*)mk_fwd, 512, LDS_BYTES) != hipSuccess || per_cu < 1) { fprintf(stderr, "kernel_launch: occupancy query says %d\n", per_cu); per_cu = 1; }
        (void)hipGetLastError();
        grid = cus;
    }
    if (grid < 0) return;
    if (hipMemsetAsync((char*)d_ws + WS_CTL, 0, 16384, stream) != hipSuccess) { fprintf(stderr, "kernel_launch: memset failed\n"); return; }
    Args a{};
    for (int i = 0; i < 14; ++i) a.in[i] = (const float*)d_in[i];
    a.out = (float*)d_out; a.ws = (unsigned char*)d_ws;
#ifndef PROBE_SEQ
#define PROBE_SEQ 0
#endif
    int n = 0;
    for (int ph = 0; ph < NPHASE; ++ph) {
        a.seq[n++] = (unsigned char)ph;
#if PROBE_SEQ == 1
        if (ph == 0) for (int k = 0; k < 50; ++k) a.seq[n++] = 30;
#elif PROBE_SEQ == 2
        if (ph == 1 || ph == 8) a.seq[n++] = (unsigned char)ph;
#elif PROBE_SEQ == 3
        if (ph == 3 || ph == 10) { a.seq[n++] = (unsigned char)(ph - 2); a.seq[n++] = (unsigned char)(ph - 1); a.seq[n++] = (unsigned char)ph; }
#elif PROBE_SEQ == 4
        if (ph == 16 || ph == 21 || ph == 0) a.seq[n++] = (unsigned char)ph;
#elif PROBE_SEQ == 6
        if (ph == 2 || ph == 9) a.seq[n++] = (unsigned char)ph;
#elif PROBE_SEQ == 5
        if (ph == 6 || ph == 13 || ph == 18 || ph == 23) a.seq[n++] = (unsigned char)ph;
#endif
    }
    a.nseq = n;
    void* args[] = {&a};
    hipError_t e = hipLaunchCooperativeKernel((const void*)mk_fwd, dim3(grid), dim3(512), args, LDS_BYTES, stream);
    if (e != hipSuccess) fprintf(stderr, "cooperative launch failed: %s (grid %d)\n", hipGetErrorString(e), grid);
}
```
